# Optimizing an MI355X kernel written in HIP

```python
import jax
import jax.numpy as jnp
from jax import lax
import numpy as np

D_MODEL = 2048
BATCH = 4
SEQ = 4096
DEPTH = 2

GRID_W = 64
CTX_LEN = 256
EPS = 1e-6
ROPE_THETA = 10000.0
Q_BLOCK = 128
MOD_CHUNKS = 6

GQA_HEADS = 8
GQA_KV_HEADS = 2
GQA_GROUP = GQA_HEADS // GQA_KV_HEADS
GQA_HEAD_DIM = 128
MLA_HEADS = 8
MLA_Q_RANK = 512
MLA_KV_RANK = 512
MLA_NOPE = 128
MLA_ROPE = 64
MLA_V = 128
ATTN_SIZES = (GQA_HEADS * GQA_HEAD_DIM, GQA_KV_HEADS * GQA_HEAD_DIM, GQA_KV_HEADS * GQA_HEAD_DIM,
              MLA_Q_RANK, MLA_KV_RANK, MLA_ROPE)
ATTN_IN_WIDTH = sum(ATTN_SIZES)
ATTN_SPLIT_IDX = tuple(int(v) for v in np.cumsum(ATTN_SIZES)[:-1])

LRU_WIDTH = 1024
LRU_BLOCKS = 8
LRU_BLOCK_W = LRU_WIDTH // LRU_BLOCKS
LRU_CONV = 4
LRU_CONV_PAD = (2, 1)
LRU_C = 8.0
HG_HEADS = 8
HG_HEAD_DIM = 128
HG_WIDTH = HG_HEADS * HG_HEAD_DIM
HG_CHUNK = 64
REC_SIZES = (LRU_WIDTH, LRU_WIDTH, HG_WIDTH, HG_WIDTH, HG_WIDTH, HG_WIDTH, HG_WIDTH)
REC_IN_WIDTH = sum(REC_SIZES)
REC_SPLIT_IDX = tuple(int(v) for v in np.cumsum(REC_SIZES)[:-1])

MIX_WIDTH = GQA_HEADS * GQA_HEAD_DIM + MLA_HEADS * MLA_V
FFN_HIDDEN = -(-8 * D_MODEL // (3 * 256)) * 256
N_ATTN = (DEPTH + 1) // 2
N_REC = DEPTH // 2

kernel_name = "hybrid_gqa_mla_rglru_hgrn2_dit_block"


def rms_norm(x, w):
    xf = x.astype(jnp.float32)
    y = xf * lax.rsqrt(jnp.mean(xf * xf, axis=-1, keepdims=True) + EPS)
    return (y * w.astype(jnp.float32)).astype(x.dtype)


def modulate(x, shift, scale):
    return x * (1 + scale) + shift


def axial_rope(row_id, col_id, dim):
    quarter = dim // 4
    inv_freq = ROPE_THETA ** (-jnp.arange(quarter, dtype=jnp.float32) / quarter)
    ang = jnp.concatenate([row_id[:, None].astype(jnp.float32) * inv_freq,
                           col_id[:, None].astype(jnp.float32) * inv_freq], axis=-1)
    return jnp.cos(ang), jnp.sin(ang)


def apply_rope(x, cos, sin):
    shape = (1, x.shape[1]) + (1,) * (x.ndim - 3) + (cos.shape[-1],)
    cos = cos.reshape(shape).astype(x.dtype)
    sin = sin.reshape(shape).astype(x.dtype)
    x1, x2 = jnp.split(x, 2, axis=-1)
    return jnp.concatenate([x1 * cos - x2 * sin, x2 * cos + x1 * sin], axis=-1)


def block_attention(q, k, v, scale):
    b, s, hk, g, dq = q.shape
    nb = s // Q_BLOCK
    qb = jnp.moveaxis(q.reshape(b, nb, Q_BLOCK, hk, g, dq), 1, 0)

    def one_block(qi):
        sc = jnp.einsum('bqhgd,bkhd->bhgqk', qi, k).astype(jnp.float32) * scale
        p = jax.nn.softmax(sc, axis=-1).astype(v.dtype)
        return jnp.einsum('bhgqk,bkhd->bqhgd', p, v)

    out = lax.map(one_block, qb)
    return jnp.moveaxis(out, 0, 1).reshape(b, s, hk, g, v.shape[-1])


def attention_heads(u, w, rope_a, rope_b):
    w_in, q_norm_w, k_norm_w, mq_norm_w, m_uq_w, mkv_norm_w, m_ukv_w = w
    b, s, _ = u.shape
    qa, ka, va, cq, ckv, kr = jnp.split(u @ w_in, ATTN_SPLIT_IDX, axis=-1)
    qa = rms_norm(qa.reshape(b, s, GQA_KV_HEADS, GQA_GROUP, GQA_HEAD_DIM), q_norm_w)
    ka = rms_norm(ka.reshape(b, s, GQA_KV_HEADS, GQA_HEAD_DIM), k_norm_w)
    va = va.reshape(b, s, GQA_KV_HEADS, GQA_HEAD_DIM)
    qb = (rms_norm(cq, mq_norm_w) @ m_uq_w).reshape(b, s, MLA_HEADS, MLA_NOPE + MLA_ROPE)
    kvb = (rms_norm(ckv, mkv_norm_w) @ m_ukv_w).reshape(b, s, MLA_HEADS, MLA_NOPE + MLA_V)
    qb_nope, qb_rope = jnp.split(qb, [MLA_NOPE], axis=-1)
    kb_nope, vb = jnp.split(kvb, [MLA_NOPE], axis=-1)
    kr = kr[:, :, None, :]
    if rope_a is not None:
        qa = apply_rope(qa, *rope_a)
        ka = apply_rope(ka, *rope_a)
        qb_rope = apply_rope(qb_rope, *rope_b)
        kr = apply_rope(kr, *rope_b)
    qb = jnp.concatenate([qb_nope, qb_rope], axis=-1)[:, :, :, None, :]
    kb = jnp.concatenate([kb_nope, jnp.broadcast_to(kr, (b, s, MLA_HEADS, MLA_ROPE))], axis=-1)
    return qa, ka, va, qb, kb, vb


def attention_mixer(u_lat, u_ctx, rope_a, rope_b, w, need_ctx):
    qa_l, ka_l, va_l, qb_l, kb_l, vb_l = attention_heads(u_lat, w, rope_a, rope_b)
    qa_c, ka_c, va_c, qb_c, kb_c, vb_c = attention_heads(u_ctx, w, None, None)
    sa = GQA_HEAD_DIM ** -0.5
    sb = (MLA_NOPE + MLA_ROPE) ** -0.5
    b, s, _ = u_lat.shape

    def cat(c_, l_):
        return jnp.concatenate([c_, l_], axis=1)

    o_lat = jnp.concatenate([
        block_attention(qa_l, cat(ka_c, ka_l), cat(va_c, va_l), sa).reshape(b, s, -1),
        block_attention(qb_l, cat(kb_c, kb_l), cat(vb_c, vb_l), sb).reshape(b, s, -1)], axis=-1)
    o_ctx = None
    if need_ctx:
        sc = u_ctx.shape[1]
        o_ctx = jnp.concatenate([
            block_attention(qa_c, ka_c, va_c, sa).reshape(b, sc, -1),
            block_attention(qb_c, kb_c, vb_c, sb).reshape(b, sc, -1)], axis=-1)
    return o_lat, o_ctx


def short_conv(x, w, bias):
    y = lax.conv_general_dilated(x, w[:, None, :].astype(x.dtype), window_strides=(1,),
                                 padding=[LRU_CONV_PAD], dimension_numbers=('NWC', 'WIO', 'NWC'),
                                 feature_group_count=x.shape[-1])
    return y + bias


def rglru_coeffs(xc, ra_w, ra_b, ix_w, ix_b, lam):
    b, s, _ = xc.shape
    xb = xc.reshape(b, s, LRU_BLOCKS, LRU_BLOCK_W)
    r = jax.nn.sigmoid(jnp.einsum('bsnc,ncd->bsnd', xb, ra_w) + ra_b).reshape(b, s, LRU_WIDTH)
    i = jax.nn.sigmoid(jnp.einsum('bsnc,ncd->bsnd', xb, ix_w) + ix_b).reshape(b, s, LRU_WIDTH)
    log_a = -LRU_C * r.astype(jnp.float32) * jax.nn.softplus(-lam.astype(jnp.float32))
    gated_x = (i * xc).astype(jnp.float32)
    return jnp.exp(log_a), jnp.sqrt(-jnp.expm1(2.0 * log_a)) * gated_x


def _lin_combine(e1, e2):
    a1, b1 = e1
    a2, b2 = e2
    return a1 * a2, a2 * b1 + b2


def linear_scan(a, b, h0, reverse):
    if h0 is not None:
        edge = -1 if reverse else 0
        b = b.at[:, edge].add(a[:, edge] * h0)
    _, h = lax.associative_scan(_lin_combine, (a, b), axis=1, reverse=reverse)
    return h


def hg_heads(a):
    b, s, _ = a.shape
    return a.reshape(b, s, HG_HEADS, HG_HEAD_DIM)


def hg_forget(pf, lb):
    f = lb + (1.0 - lb) * jax.nn.sigmoid(pf.astype(jnp.float32))
    return hg_heads(1.0 - f), hg_heads(jnp.log(f))


def hgrn2_chunk_scan(q, k, v, logf, s0, with_output):
    q, k, v, logf = (a.astype(jnp.float32) for a in (q, k, v, logf))
    b, t, h, dk = q.shape
    n = t // HG_CHUNK

    def chunks(a):
        return jnp.moveaxis(a.reshape(b, n, HG_CHUNK, h, a.shape[-1]), 1, 0)

    causal = jnp.tril(jnp.ones((HG_CHUNK, HG_CHUNK), dtype=bool))[None, :, :, None, None]

    def step(S, inp):
        qc, kc, vc, gc = inp
        cum = jnp.cumsum(gc, axis=1)
        last = cum[:, -1]
        S_new = jnp.exp(last)[..., None] * S + jnp.einsum('bshd,bshv->bhdv', kc * jnp.exp(last[:, None] - cum), vc)
        if not with_output:
            return S_new, None
        decay = jnp.exp(jnp.where(causal, cum[:, :, None] - cum[:, None], -jnp.inf))
        scores = jnp.einsum('bthd,bshd,btshd->bhts', qc, kc, decay)
        o = jnp.einsum('bhts,bshv->bthv', scores, vc) + jnp.einsum('bthd,bhdv->bthv', qc * jnp.exp(cum), S)
        return S_new, o

    if s0 is None:
        s0 = jnp.zeros((b, h, dk, v.shape[-1]), jnp.float32)
    S, o = lax.scan(step, s0, (chunks(q), chunks(k), chunks(v), chunks(logf)))
    if with_output:
        o = jnp.moveaxis(o, 0, 1).reshape(b, t, h, v.shape[-1])
    return S, o


def hgrn2_direction(q, k, v, logf, s0, reverse, with_output):
    if reverse:
        q, k, v, logf = (jnp.flip(a, axis=1) for a in (q, k, v, logf))
    S, o = hgrn2_chunk_scan(q, k, v, logf, s0, with_output)
    if reverse and with_output:
        o = jnp.flip(o, axis=1)
    return S, o


def hg_out(o, g, norm_w):
    b, s = o.shape[:2]
    y = rms_norm(o, norm_w.reshape(HG_HEADS, HG_HEAD_DIM)).reshape(b, s, HG_WIDTH)
    return y.astype(g.dtype) * jax.nn.silu(g)


def recurrent_mixer(u_lat, u_ctx, w_in, conv_w, conv_b, ra_w, ra_b, ix_w, ix_b, lam, lb, hg_norm_w, need_ctx):
    p_lat = jnp.split(u_lat @ w_in, REC_SPLIT_IDX, axis=-1)
    p_ctx = jnp.split(u_ctx @ w_in, REC_SPLIT_IDX, axis=-1)
    xc_lat = short_conv(p_lat[0], conv_w, conv_b)
    xc_ctx = short_conv(p_ctx[0], conv_w, conv_b)
    q_lat, v_lat = hg_heads(jax.nn.silu(p_lat[2])), hg_heads(p_lat[5])
    q_ctx, v_ctx = hg_heads(jax.nn.silu(p_ctx[2])), hg_heads(p_ctx[5])
    lru_lat, lru_ctx, hg_lat, hg_ctx = 0.0, 0.0, 0.0, 0.0
    for d, rev in enumerate((False, True)):
        a_c, b_c = rglru_coeffs(xc_ctx, ra_w[d], ra_b[d], ix_w[d], ix_b[d], lam[d])
        h_c = linear_scan(a_c, b_c, None, rev)
        a_l, b_l = rglru_coeffs(xc_lat, ra_w[d], ra_b[d], ix_w[d], ix_b[d], lam[d])
        h_l = linear_scan(a_l, b_l, h_c[:, 0] if rev else h_c[:, -1], rev)
        lru_lat = lru_lat + h_l
        k_c, g_c = hg_forget(p_ctx[3 + d], lb[d])
        s_c, o_c = hgrn2_direction(q_ctx, k_c, v_ctx, g_c, None, rev, need_ctx)
        k_l, g_l = hg_forget(p_lat[3 + d], lb[d])
        _, o_l = hgrn2_direction(q_lat, k_l, v_lat, g_l, s_c, rev, True)
        hg_lat = hg_lat + o_l
        if need_ctx:
            lru_ctx = lru_ctx + h_c
            hg_ctx = hg_ctx + o_c
    y_lat = jnp.concatenate([jax.nn.gelu(p_lat[1]) * lru_lat.astype(p_lat[1].dtype),
                             hg_out(hg_lat, p_lat[6], hg_norm_w)], axis=-1)
    y_ctx = None
    if need_ctx:
        y_ctx = jnp.concatenate([jax.nn.gelu(p_ctx[1]) * lru_ctx.astype(p_ctx[1].dtype),
                                 hg_out(hg_ctx, p_ctx[6], hg_norm_w)], axis=-1)
    return y_lat, y_ctx


def swiglu(u, w_gate, w_up, w_down):
    return (jax.nn.silu(u @ w_gate) * (u @ w_up)) @ w_down


def setup_inputs(seed: int = 0) -> dict:
    key = jax.random.key(seed)
    ks = iter(jax.random.split(key, 32))
    f32 = jnp.float32

    def nrm(shape, fan_in):
        return jax.random.normal(next(ks), shape, f32) * fan_in ** -0.5

    def gain(shape):
        return 1.0 + 0.05 * jax.random.normal(next(ks), shape, f32)

    def bias(shape):
        return 0.02 * jax.random.normal(next(ks), shape, f32)

    x = jax.random.normal(next(ks), (BATCH, SEQ, D_MODEL), f32)
    c = jax.random.normal(next(ks), (BATCH, D_MODEL), f32)
    ctx = jax.random.normal(next(ks), (BATCH, CTX_LEN, D_MODEL), f32)
    c_ctx = jax.random.normal(next(ks), (D_MODEL,), f32)
    mod_w = 0.5 * nrm((DEPTH, D_MODEL, MOD_CHUNKS * D_MODEL), D_MODEL)
    mod_b = bias((DEPTH, MOD_CHUNKS * D_MODEL))
    norm_mix_w = gain((DEPTH, D_MODEL))
    norm_ffn_w = gain((DEPTH, D_MODEL))
    mix_out_w = nrm((DEPTH, MIX_WIDTH, D_MODEL), MIX_WIDTH)
    ffn_gate_w = nrm((DEPTH, D_MODEL, FFN_HIDDEN), D_MODEL)
    ffn_up_w = nrm((DEPTH, D_MODEL, FFN_HIDDEN), D_MODEL)
    ffn_down_w = nrm((DEPTH, FFN_HIDDEN, D_MODEL), FFN_HIDDEN)
    attn_in_w = nrm((N_ATTN, D_MODEL, ATTN_IN_WIDTH), D_MODEL)
    gqa_q_norm_w = gain((N_ATTN, GQA_HEAD_DIM))
    gqa_k_norm_w = gain((N_ATTN, GQA_HEAD_DIM))
    mla_q_norm_w = gain((N_ATTN, MLA_Q_RANK))
    mla_uq_w = nrm((N_ATTN, MLA_Q_RANK, MLA_HEADS * (MLA_NOPE + MLA_ROPE)), MLA_Q_RANK)
    mla_kv_norm_w = gain((N_ATTN, MLA_KV_RANK))
    mla_ukv_w = nrm((N_ATTN, MLA_KV_RANK, MLA_HEADS * (MLA_NOPE + MLA_V)), MLA_KV_RANK)
    rec_in_w = nrm((N_REC, D_MODEL, REC_IN_WIDTH), D_MODEL)
    lru_conv_w = nrm((N_REC, LRU_CONV, LRU_WIDTH), LRU_CONV)
    lru_conv_b = bias((N_REC, LRU_WIDTH))
    lru_ra_w = nrm((N_REC, 2, LRU_BLOCKS, LRU_BLOCK_W, LRU_BLOCK_W), LRU_BLOCK_W)
    lru_ra_b = bias((N_REC, 2, LRU_BLOCKS, LRU_BLOCK_W))
    lru_ix_w = nrm((N_REC, 2, LRU_BLOCKS, LRU_BLOCK_W, LRU_BLOCK_W), LRU_BLOCK_W)
    lru_ix_b = bias((N_REC, 2, LRU_BLOCKS, LRU_BLOCK_W))
    a_pow_c = jax.random.uniform(next(ks), (N_REC, 2, LRU_WIDTH), f32, 0.9, 0.999)
    a0 = a_pow_c ** (1.0 / LRU_C)
    lru_lambda = jnp.log(a0) - jnp.log1p(-a0)
    hgrn_lb_logits = jax.random.normal(next(ks), (2, DEPTH, HG_WIDTH), f32)
    hgrn_norm_w = gain((N_REC, HG_WIDTH))
    final_norm_w = gain((D_MODEL,))
    return {"x": x, "c": c, "ctx": ctx, "c_ctx": c_ctx, "mod_w": mod_w, "mod_b": mod_b,
            "norm_mix_w": norm_mix_w, "norm_ffn_w": norm_ffn_w, "mix_out_w": mix_out_w,
            "ffn_gate_w": ffn_gate_w, "ffn_up_w": ffn_up_w, "ffn_down_w": ffn_down_w,
            "attn_in_w": attn_in_w, "gqa_q_norm_w": gqa_q_norm_w, "gqa_k_norm_w": gqa_k_norm_w,
            "mla_q_norm_w": mla_q_norm_w, "mla_uq_w": mla_uq_w, "mla_kv_norm_w": mla_kv_norm_w,
            "mla_ukv_w": mla_ukv_w, "rec_in_w": rec_in_w, "lru_conv_w": lru_conv_w,
            "lru_conv_b": lru_conv_b, "lru_ra_w": lru_ra_w, "lru_ra_b": lru_ra_b,
            "lru_ix_w": lru_ix_w, "lru_ix_b": lru_ix_b, "lru_lambda": lru_lambda,
            "hgrn_lb_logits": hgrn_lb_logits, "hgrn_norm_w": hgrn_norm_w, "final_norm_w": final_norm_w}


def reference(x, c, ctx, c_ctx, mod_w, mod_b, norm_mix_w, norm_ffn_w, mix_out_w, ffn_gate_w, ffn_up_w,
              ffn_down_w, attn_in_w, gqa_q_norm_w, gqa_k_norm_w, mla_q_norm_w, mla_uq_w, mla_kv_norm_w,
              mla_ukv_w, rec_in_w, lru_conv_w, lru_conv_b, lru_ra_w, lru_ra_b, lru_ix_w, lru_ix_b,
              lru_lambda, hgrn_lb_logits, hgrn_norm_w, final_norm_w):
    seq = x.shape[1]
    rows = seq // GRID_W
    row_id = jnp.repeat(jnp.arange(rows), GRID_W)
    col_id = jnp.arange(rows * GRID_W) % GRID_W
    rope_a = axial_rope(row_id, col_id, GQA_HEAD_DIM)
    rope_b = axial_rope(row_id, col_id, MLA_ROPE)
    lb_all = jnp.cumsum(jax.nn.softmax(hgrn_lb_logits.astype(jnp.float32), axis=1), axis=1)
    lb_all = lb_all - lb_all[:, :1]
    silu_c = jax.nn.silu(c)
    silu_cc = jax.nn.silu(c_ctx)
    h_lat, h_ctx = x, ctx
    for l in range(DEPTH):
        need_ctx = l < DEPTH - 1
        j = l // 2
        mod_lat = (silu_c @ mod_w[l] + mod_b[l])[:, None, :]
        mod_ctx = silu_cc @ mod_w[l] + mod_b[l]
        sh1, sc1, g1, sh2, sc2, g2 = jnp.split(mod_lat, MOD_CHUNKS, axis=-1)
        csh1, csc1, cg1, csh2, csc2, cg2 = jnp.split(mod_ctx, MOD_CHUNKS, axis=-1)
        u_lat = modulate(rms_norm(h_lat, norm_mix_w[l]), sh1, sc1)
        u_ctx = modulate(rms_norm(h_ctx, norm_mix_w[l]), csh1, csc1)
        if l % 2 == 0:
            w = (attn_in_w[j], gqa_q_norm_w[j], gqa_k_norm_w[j], mla_q_norm_w[j], mla_uq_w[j],
                 mla_kv_norm_w[j], mla_ukv_w[j])
            m_lat, m_ctx = attention_mixer(u_lat, u_ctx, rope_a, rope_b, w, need_ctx)
        else:
            m_lat, m_ctx = recurrent_mixer(u_lat, u_ctx, rec_in_w[j], lru_conv_w[j], lru_conv_b[j],
                                           lru_ra_w[j], lru_ra_b[j], lru_ix_w[j], lru_ix_b[j],
                                           lru_lambda[j], lb_all[:, l], hgrn_norm_w[j], need_ctx)
        h_lat = h_lat + g1 * (m_lat @ mix_out_w[l])
        h_lat = h_lat + g2 * swiglu(modulate(rms_norm(h_lat, norm_ffn_w[l]), sh2, sc2),
                                    ffn_gate_w[l], ffn_up_w[l], ffn_down_w[l])
        if need_ctx:
            h_ctx = h_ctx + cg1 * (m_ctx @ mix_out_w[l])
            h_ctx = h_ctx + cg2 * swiglu(modulate(rms_norm(h_ctx, norm_ffn_w[l]), csh2, csc2),
                                         ffn_gate_w[l], ffn_up_w[l], ffn_down_w[l])
    return rms_norm(h_lat, final_norm_w)
```

```cpp
#include <hip/hip_runtime.h>
#include <hip/hip_bf16.h>
#include <hip/hip_cooperative_groups.h>
#include <cstdio>
#include <cstdint>
namespace cg = cooperative_groups;

constexpr int DM = 2048, NBATCH = 4, SEQL = 4096, CTXL = 256, TPB = SEQL + CTXL, MT = NBATCH * TPB;
constexpr int FFH = 5632, AIW = 2624, AIWP = 2816, RIW = 7168, MODW = 6 * DM;
constexpr float EPS = 1e-6f;
constexpr size_t MiB = 1u << 20;
constexpr size_t WS_MOD = 0;
constexpr size_t WS_COSA = 1 * MiB, WS_SINA = 2 * MiB;
constexpr size_t WS_COSB = 3 * MiB, WS_SINB = 3 * MiB + 512 * 1024;
constexpr size_t WS_LB = 4 * MiB, WS_SP8 = 4 * MiB + 8192;
constexpr size_t WS_CARR = 5 * MiB;
constexpr size_t WS_HGD = 10 * MiB;
constexpr size_t WS_H = 16 * MiB;
constexpr size_t WS_U = 152 * MiB;
constexpr size_t WS_MIX = 220 * MiB;
constexpr size_t WS_WREC = 288 * MiB, WS_WLRU = 316 * MiB, WS_WMIX1 = 318 * MiB, WS_WGU1 = 326 * MiB, WS_WD1 = 370 * MiB;
constexpr size_t WS_WATT = 392 * MiB, WS_WUQ = 403 * MiB, WS_WUKV = 405 * MiB, WS_WMIX0 = 407 * MiB, WS_WGU0 = 415 * MiB, WS_WD0 = 459 * MiB;
constexpr size_t WS_F = 482 * MiB;
constexpr size_t WS_PROJ = WS_F;
constexpr size_t WS_QA = 576 * MiB, WS_KA = 610 * MiB, WS_CQN = 619 * MiB, WS_CKVN = 636 * MiB, WS_KR = 653 * MiB, WS_QB = 656 * MiB;
constexpr size_t WS_KVB = WS_U;
constexpr size_t WS_HID = WS_F;
constexpr size_t WS_LAB = 392 * MiB;
constexpr size_t WS_SS = WS_LAB;
constexpr size_t WS_PREC = 528 * MiB;
constexpr size_t WS_XC = WS_U;
constexpr size_t WS_END = 768 * MiB;
constexpr int LDS_BYTES = 147456;

#define LAS __attribute__((address_space(3)))
typedef unsigned short bf16;
typedef unsigned v4u __attribute__((ext_vector_type(4)));
typedef unsigned v2u __attribute__((ext_vector_type(2)));
typedef float f32x4 __attribute__((ext_vector_type(4)));
typedef short bf16x8 __attribute__((ext_vector_type(8)));
typedef __bf16 bf2_t __attribute__((ext_vector_type(2)));
typedef float f2_t __attribute__((ext_vector_type(2)));
__device__ __forceinline__ unsigned cvtpk(float lo, float hi) { f2_t v = {lo, hi}; bf2_t r = __builtin_convertvector(v, bf2_t); return __builtin_bit_cast(unsigned, r); }
__device__ __forceinline__ float bflo(unsigned w) { return __uint_as_float(w << 16); }
__device__ __forceinline__ float bfhi(unsigned w) { return __uint_as_float(w & 0xffff0000u); }
__device__ __forceinline__ float bf2f(bf16 h) { return __uint_as_float((unsigned)h << 16); }
__device__ __forceinline__ bf16 f2bf(float f) { return (bf16)(cvtpk(f, f) & 0xffffu); }
__device__ __forceinline__ float wave_sum(float v) {
#pragma unroll
    for (int o = 1; o < 64; o <<= 1) v += __shfl_xor(v, o);
    return v;
}
__device__ __forceinline__ float sigmoidf_(float x) { return __builtin_amdgcn_rcpf(1.f + __expf(-x)); }
__device__ __forceinline__ float siluf_(float x) { return x * sigmoidf_(x); }
#define LDS_WAIT() asm volatile("s_waitcnt lgkmcnt(0)" ::: "memory")
namespace pg8 {
#define PG8_LAS __attribute__((address_space(3)))
typedef unsigned short bf16_t;
typedef short bf16x8 __attribute__((ext_vector_type(8)));
typedef float f32x4 __attribute__((ext_vector_type(4)));
typedef unsigned u32x4 __attribute__((ext_vector_type(4)));
constexpr int BM = 256, BK = 64, HALF = 128, HTB = HALF * BK * 2  , STAGE_BYTES = 8 * HTB, NXCD = 8, WGM = 8;

__host__ __device__ __forceinline__ int lds_byte(int r, int c) { const int st = (r >> 4) * 2 + (c >> 5), rr = r & 15, cc = c & 31, ob = rr * 64 + cc * 2; return st * 1024 + (ob ^ (((ob >> 9) & 1) << 5)); }
__host__ __device__ __forceinline__ void stage_rc(int b, int& R, int& C) { const int st = b / 1024, sb = b % 1024, swz = sb ^ (((sb >> 9) & 1) << 5); R = (st >> 1) * 16 + swz / 64; C = (st & 1) * 32 + (swz % 64) / 2; }
__host__ __device__ __forceinline__ int perm32(int rho) { const int n = rho >> 4, i = rho & 15; return 8 * (i >> 2) + 4 * n + (i & 3); }
struct Unit { int pm, pn; };
struct Gemm { const bf16_t* A; const bf16_t* Bt; int M, N, K, lda, grp;
    __device__ __forceinline__ const char* abase(const Unit& u) const { return (const char*)A + (size_t)u.pm * 256 * lda * 2 + (grp ? (size_t)(u.pn >> 2) * 512 : 0); } };
struct StaticOrder {
    int nM, nN, nwg, G, c, skip;
    __device__ void init(int M, int N, int G_, int c_, int skip_) { skip = skip_; nM = skip_ ? 64 : M / BM; nN = N / BM; nwg = nM * nN; G = G_; c = c_; }
    __device__ bool next(int i, Unit& u) const {
        const long L = (long)i * G + c; if (L >= nwg) return false;
        int wgid = (int)L; { const int q = nwg / NXCD, r = nwg % NXCD, xcd = wgid % NXCD, off = wgid / NXCD; wgid = (xcd < r ? xcd * (q + 1) : r * (q + 1) + (xcd - r) * q) + off; }
        const int nig = WGM * nN, gid = wgid / nig, fm = gid * WGM, gsz = (nM - fm) < WGM ? (nM - fm) : WGM;
        int pm = fm + ((wgid % nig) % gsz); u.pn = (wgid % nig) / gsz;
        if (skip) pm = (pm >> 4) * 17 + 1 + (pm & 15);
        u.pm = pm; return true;
    }
    __device__ __forceinline__ void a_ready(const Unit&) const {}
    __device__ __forceinline__ void done(const Unit&) const {}
};
__device__ __forceinline__ unsigned cvt_pk_bf16(float lo, float hi) { return ::cvtpk(lo, hi); }
__device__ __forceinline__ float sigm(float x) { return __builtin_amdgcn_rcpf(1.f + __expf(-x)); }
struct EpiStore {
    static constexpr bool PERM = true, AFTER_DRAIN = false;
    bf16_t* O; int ldc;
    __device__ __forceinline__ void operator()(const f32x4 (&acc)[2][2][4][2], const Unit& u, int wr, int wc, int fr, int fq) const {
        const int row0 = u.pm * BM + wr * 64 + fr, col0 = u.pn * BM + wc * 32 + 8 * fq;
#pragma unroll
        for (int ai = 0; ai < 2; ++ai)
#pragma unroll
            for (int m = 0; m < 4; ++m) { bf16_t* rowp = O + (size_t)(row0 + ai * HALF + m * 16) * ldc + col0;
#pragma unroll
                for (int bj = 0; bj < 2; ++bj) { const f32x4 v0 = acc[ai][bj][m][0], v1 = acc[ai][bj][m][1];
                    u32x4 w; w.x = cvt_pk_bf16(v0[0], v0[1]); w.y = cvt_pk_bf16(v0[2], v0[3]); w.z = cvt_pk_bf16(v1[0], v1[1]); w.w = cvt_pk_bf16(v1[2], v1[3]);
                    *(u32x4*)(rowp + bj * HALF) = w; } }
    }
};
struct EpiSwiGLU {
    static constexpr bool PERM = true, AFTER_DRAIN = false;
    bf16_t* O; int ldc;
    __device__ __forceinline__ void operator()(const f32x4 (&acc)[2][2][4][2], const Unit& u, int wr, int wc, int fr, int fq) const {
        const int row0 = u.pm * BM + wr * 64 + fr, col0 = u.pn * HALF + wc * 32 + 8 * fq;
#pragma unroll
        for (int ai = 0; ai < 2; ++ai)
#pragma unroll
            for (int m = 0; m < 4; ++m) { bf16_t* rowp = O + (size_t)(row0 + ai * HALF + m * 16) * ldc + col0;
                float r[8];
#pragma unroll
                for (int n = 0; n < 2; ++n)
#pragma unroll
                    for (int e = 0; e < 4; ++e) { const float g = acc[ai][0][m][n][e], up = acc[ai][1][m][n][e]; r[n * 4 + e] = g * sigm(g) * up; }
                u32x4 w; w.x = cvt_pk_bf16(r[0], r[1]); w.y = cvt_pk_bf16(r[2], r[3]); w.z = cvt_pk_bf16(r[4], r[5]); w.w = cvt_pk_bf16(r[6], r[7]);
                *(u32x4*)rowp = w; }
    }
};
struct EpiResGate {
    static constexpr bool PERM = false, AFTER_DRAIN = false;
    float* H; const float* gate;
    __device__ __forceinline__ void operator()(const f32x4 (&acc)[2][2][4][2], const Unit& u, int wr, int wc, int fr, int fq) const {
        const int cond = (u.pm % 17 == 0) ? 4 : u.pm / 17;
        const float* gv = gate + (size_t)cond * 12288;
        const int row0 = u.pm * BM + wr * 64 + fr, col0 = u.pn * BM + wc * 32 + 4 * fq;
        f32x4 g4[2][2];
#pragma unroll
        for (int bj = 0; bj < 2; ++bj)
#pragma unroll
            for (int n = 0; n < 2; ++n) g4[bj][n] = *(const f32x4*)(gv + col0 + bj * HALF + n * 16);
#pragma unroll
        for (int ai = 0; ai < 2; ++ai)
#pragma unroll
            for (int m = 0; m < 4; ++m) { float* rowp = H + (size_t)(row0 + ai * HALF + m * 16) * 2048 + col0;
#pragma unroll
                for (int bj = 0; bj < 2; ++bj)
#pragma unroll
                    for (int n = 0; n < 2; ++n) { f32x4* p = (f32x4*)(rowp + bj * HALF + n * 16); *p = *p + g4[bj][n] * acc[ai][bj][m][n]; }
                asm volatile("" ::: "memory"); }
    }
};
template <class Epi, class Sched, bool ALIGN_EPI = false, bool SP2 = false>
__device__ __forceinline__ void gemm_phase(PG8_LAS unsigned char* lds, const Gemm g, const Sched& S, const Epi& E) {
    const int tid = threadIdx.x, wid = __builtin_amdgcn_readfirstlane(tid >> 6), lane = tid & 63, wr = wid >> 2, wc = wid & 3, fr = lane & 15, fq = lane >> 4;
    const int K = g.K, nt = K / BK;
    unsigned voffA[2], voffB[2];
#pragma unroll
    for (int i = 0; i < 2; ++i) { int R, C; stage_rc(tid * 16 + i * 8192, R, C); const int Rb = Epi::PERM ? ((R & ~31) + perm32(R & 31)) : R;
        voffA[i] = (unsigned)(R * g.lda + C) * 2u; voffB[i] = (unsigned)(Rb * K + C) * 2u; }
    const size_t kstep = (size_t)(BK * 2);
    const size_t hstep = (size_t)HALF * K * 2; const size_t hstepA = (size_t)HALF * g.lda * 2;
    const size_t tstep = 2 * hstep;
    const unsigned ldsw = (unsigned)wid * 1024u;
    const int aoff = lds_byte(wr * 64 + fr, fq * 8), boff = lds_byte(wc * 32 + fr, fq * 8);
#define PG8_SA(b, h) (((b) * 2 + (h)) * HTB)
#define PG8_SB(b, h) ((4 + (b) * 2 + (h)) * HTB)
#define PG8_STAGE(bufoff, gbase, voff) do { _Pragma("unroll") for (int _i = 0; _i < 2; ++_i) \
        __builtin_amdgcn_global_load_lds((const unsigned*)((const char*)(gbase) + (voff)[_i]), (PG8_LAS unsigned*)(lds + (bufoff) + ldsw + _i * 8192), 16, 0, 0); } while (0)
#define PG8_LDA(dst, b, h) do { _Pragma("unroll") for (int m = 0; m < 4; ++m) _Pragma("unroll") for (int k = 0; k < 2; ++k) dst[m][k] = *(const PG8_LAS bf16x8*)(lds + PG8_SA(b, h) + aoff + m * 2048 + k * 1024); } while (0)
#define PG8_LDB(dst, b, h) do { _Pragma("unroll") for (int n = 0; n < 2; ++n) _Pragma("unroll") for (int k = 0; k < 2; ++k) dst[n][k] = *(const PG8_LAS bf16x8*)(lds + PG8_SB(b, h) + boff + n * 2048 + k * 1024); } while (0)
#define PG8_MMA(ai, bj, At, Bt) do { __builtin_amdgcn_s_setprio(1); _Pragma("unroll") for (int m = 0; m < 4; ++m) _Pragma("unroll") for (int n = 0; n < 2; ++n) _Pragma("unroll") for (int k = 0; k < 2; ++k) \
        acc[ai][bj][m][n] = __builtin_amdgcn_mfma_f32_16x16x32_bf16(Bt[n][k], At[m][k], acc[ai][bj][m][n], 0, 0, 0); __builtin_amdgcn_s_setprio(0); } while (0)
#define PG8_WAIT_V(n) asm volatile("s_waitcnt vmcnt(" #n ")" ::: "memory")
#define PG8_WAIT_L(n) asm volatile("s_waitcnt lgkmcnt(" #n ")" ::: "memory")
#define PG8_BAR __builtin_amdgcn_s_barrier()
#define PG8_SCHED __builtin_amdgcn_sched_barrier(0)
    Unit cur, nxt; int ui = 0;
    if (!S.next(0, cur)) return;
    f32x4 acc[2][2][4][2];
#pragma unroll
    for (int a = 0; a < 2; ++a)
#pragma unroll
        for (int b = 0; b < 2; ++b)
#pragma unroll
            for (int m = 0; m < 4; ++m)
#pragma unroll
                for (int n = 0; n < 2; ++n) acc[a][b][m][n] = (f32x4){0.f, 0.f, 0.f, 0.f};
    bf16x8 At[4][2], B0[2][2], B1[2][2];
    const char* cA = g.abase(cur); const char* cB = (const char*)g.Bt + (size_t)cur.pn * tstep;
    S.a_ready(cur);
    if constexpr (SP2) {
        PG8_STAGE(PG8_SB(0, 0), cB, voffB); PG8_STAGE(PG8_SB(0, 1), cB + hstep, voffB); PG8_STAGE(PG8_SA(0, 0), cA, voffA); PG8_STAGE(PG8_SA(0, 1), cA + hstepA, voffA);
        if (wr == 1) PG8_BAR;
        PG8_WAIT_V(2); PG8_BAR;
        PG8_STAGE(PG8_SB(1, 0), cB + kstep, voffB); PG8_STAGE(PG8_SA(1, 0), cA + kstep, voffA); PG8_STAGE(PG8_SB(1, 1), cB + hstep + kstep, voffB);
        PG8_WAIT_V(6); PG8_BAR;
    } else {
        PG8_STAGE(PG8_SB(0, 0), cB, voffB); PG8_STAGE(PG8_SA(0, 0), cA, voffA); PG8_STAGE(PG8_SB(0, 1), cB + hstep, voffB); PG8_STAGE(PG8_SA(0, 1), cA + hstepA, voffA);
        if (wr == 1) PG8_BAR;
        PG8_WAIT_V(4); PG8_BAR;
        PG8_STAGE(PG8_SB(1, 0), cB + kstep, voffB); PG8_STAGE(PG8_SA(1, 0), cA + kstep, voffA); PG8_STAGE(PG8_SB(1, 1), cB + hstep + kstep, voffB);
        PG8_WAIT_V(6); PG8_BAR;
    }
    for (;;) {
        const bool has_next = S.next(ui + 1, nxt);
        const char* nA = has_next ? g.abase(nxt) : cA; const char* nB = has_next ? (const char*)g.Bt + (size_t)nxt.pn * tstep : cB;
        for (int t = 0; t < nt; t += 2) {
            const bool last = (t == nt - 2);
            const char* a1 = cA + (size_t)(t + 1) * kstep;
            const char* a2 = last ? nA : cA + (size_t)(t + 2) * kstep; const char* b2 = last ? nB : cB + (size_t)(t + 2) * kstep;
            const char* a3 = a2 + kstep; const char* b3 = b2 + kstep;
            if (last && has_next) S.a_ready(nxt);
            if constexpr (SP2) {
            PG8_LDB(B0, 0, 0); PG8_LDB(B1, 0, 1); PG8_SCHED; PG8_LDA(At, 0, 0); PG8_STAGE(PG8_SA(1, 1), a1 + hstepA, voffA);
            PG8_WAIT_V(8); PG8_WAIT_L(0); PG8_BAR; PG8_MMA(0, 0, At, B0); PG8_MMA(0, 1, At, B1); PG8_BAR; PG8_SCHED;
            PG8_LDA(At, 0, 1); PG8_STAGE(PG8_SB(0, 0), b2, voffB); PG8_STAGE(PG8_SB(0, 1), b2 + hstep, voffB); PG8_STAGE(PG8_SA(0, 0), a2, voffA);
            PG8_WAIT_V(8); PG8_WAIT_L(0); PG8_BAR; PG8_MMA(1, 0, At, B0); PG8_MMA(1, 1, At, B1); PG8_BAR; PG8_SCHED;
            PG8_LDB(B0, 1, 0); PG8_LDB(B1, 1, 1); PG8_SCHED; PG8_LDA(At, 1, 0); PG8_STAGE(PG8_SA(0, 1), a2 + hstepA, voffA);
            PG8_WAIT_V(8); PG8_WAIT_L(0); PG8_BAR; PG8_MMA(0, 0, At, B0); PG8_MMA(0, 1, At, B1); PG8_BAR; PG8_SCHED;
            PG8_LDA(At, 1, 1); PG8_STAGE(PG8_SB(1, 0), b3, voffB); PG8_STAGE(PG8_SB(1, 1), b3 + hstep, voffB); PG8_STAGE(PG8_SA(1, 0), a3, voffA);
            PG8_WAIT_V(8); PG8_WAIT_L(0); PG8_BAR; PG8_MMA(1, 0, At, B0); PG8_MMA(1, 1, At, B1); PG8_BAR; PG8_SCHED;
            } else {
            PG8_LDB(B0, 0, 0); PG8_SCHED; PG8_LDA(At, 0, 0); PG8_STAGE(PG8_SA(1, 1), a1 + hstepA, voffA);
            PG8_WAIT_L(8); PG8_BAR; PG8_WAIT_L(0); PG8_MMA(0, 0, At, B0); PG8_BAR; PG8_SCHED;
            PG8_LDB(B1, 0, 1); PG8_STAGE(PG8_SB(0, 0), b2, voffB);
            PG8_BAR; PG8_WAIT_L(0); PG8_MMA(0, 1, At, B1); PG8_BAR;
            PG8_LDA(At, 0, 1); PG8_STAGE(PG8_SA(0, 0), a2, voffA);
            PG8_BAR; PG8_WAIT_L(0); PG8_MMA(1, 0, At, B0); PG8_BAR; PG8_SCHED;
            PG8_STAGE(PG8_SB(0, 1), b2 + hstep, voffB);
            PG8_WAIT_V(6); PG8_BAR; PG8_MMA(1, 1, At, B1); PG8_BAR;
            PG8_LDB(B0, 1, 0); PG8_SCHED; PG8_LDA(At, 1, 0); PG8_STAGE(PG8_SA(0, 1), a2 + hstepA, voffA);
            PG8_WAIT_L(8); PG8_BAR; PG8_WAIT_L(0); PG8_MMA(0, 0, At, B0); PG8_BAR; PG8_SCHED;
            PG8_LDB(B1, 1, 1); PG8_STAGE(PG8_SB(1, 0), b3, voffB);
            PG8_BAR; PG8_WAIT_L(0); PG8_MMA(0, 1, At, B1); PG8_BAR;
            PG8_LDA(At, 1, 1); PG8_STAGE(PG8_SA(1, 0), a3, voffA);
            PG8_BAR; PG8_WAIT_L(0); PG8_MMA(1, 0, At, B0); PG8_BAR; PG8_SCHED;
            PG8_STAGE(PG8_SB(1, 1), b3 + hstep, voffB);
            PG8_WAIT_V(6); PG8_BAR; PG8_MMA(1, 1, At, B1); PG8_BAR;
            }
        }
        if constexpr (ALIGN_EPI) { if (wr == 0) PG8_BAR; }
        if constexpr (!Epi::AFTER_DRAIN) { E(acc, cur, wr, wc, fr, fq); S.done(cur); }
        if (!has_next) break;
#pragma unroll
        for (int a = 0; a < 2; ++a)
#pragma unroll
            for (int b = 0; b < 2; ++b)
#pragma unroll
                for (int m = 0; m < 4; ++m)
#pragma unroll
                    for (int n = 0; n < 2; ++n) acc[a][b][m][n] = (f32x4){0.f, 0.f, 0.f, 0.f};
        cur = nxt; cA = nA; cB = nB; ++ui;
        if constexpr (ALIGN_EPI) { if (wr == 1) PG8_BAR; }
    }
    PG8_WAIT_V(0);
    if constexpr (!ALIGN_EPI) { if (wr == 0) PG8_BAR; }
    PG8_BAR;
    if constexpr (Epi::AFTER_DRAIN) { E.fused(acc, cur, wr, wc, fr, fq, lds, wid, lane); S.done(cur); }
#undef PG8_SA
#undef PG8_SB
#undef PG8_STAGE
#undef PG8_LDA
#undef PG8_LDB
#undef PG8_MMA
#undef PG8_WAIT_V
#undef PG8_WAIT_L
#undef PG8_BAR
#undef PG8_SCHED
}
}
namespace attn {
using bf16x8 = __attribute__((ext_vector_type(8))) short;
using s16x4  = __attribute__((ext_vector_type(4))) short;
using f32x16 = __attribute__((ext_vector_type(16))) float;
using u32x4  = __attribute__((ext_vector_type(4))) unsigned;
constexpr int NW = 8, QBLK = 32, KVBLK = 64;
constexpr float THR = 8.f;
constexpr size_t SHM_V = KVBLK * 128 * 2;
#define SBAR() __builtin_amdgcn_sched_barrier(0)
__device__ __forceinline__ int crow(int r, int hi) { return (r & 3) + 8 * (r >> 2) + 4 * hi; }
__device__ __forceinline__ void partialSM(f32x16& p0, f32x16& p1, float& m_reg, float& mn, float& alpha, const float C, const float THRS) {
  float pmax = p0[0];
#pragma unroll
  for (int r = 1; r < 16; ++r) pmax = fmaxf(pmax, p0[r]);
#pragma unroll
  for (int r = 0; r < 16; ++r) pmax = fmaxf(pmax, p1[r]);
  { auto rr = __builtin_amdgcn_permlane32_swap(__float_as_uint(pmax), __float_as_uint(pmax), false, false);
    pmax = fmaxf(__uint_as_float(rr[0]), __uint_as_float(rr[1])); }
  if (__builtin_expect(__all(pmax - m_reg <= THRS), 1)) { mn = m_reg; alpha = 1.f; }
  else { mn = fmaxf(m_reg, pmax); alpha = __builtin_amdgcn_exp2f((m_reg - mn) * C); m_reg = mn; }
  float mnC = -mn * C;
#pragma unroll
  for (int r = 0; r < 16; ++r) p0[r] = fmaf(p0[r], C, mnC);
#pragma unroll
  for (int r = 0; r < 16; ++r) p1[r] = fmaf(p1[r], C, mnC);
#pragma unroll
  for (int r = 0; r < 16; ++r) p0[r] = __builtin_amdgcn_exp2f(p0[r]);
}
__device__ __forceinline__ void finishSM(f32x16& p0, f32x16& p1, float alpha, float& l_reg, bf16x8& pa0, bf16x8& pa1, bf16x8& pa2, bf16x8& pa3) {
#pragma unroll
  for (int r = 0; r < 16; ++r) p1[r] = __builtin_amdgcn_exp2f(p1[r]);
  float ps = 0;
#pragma unroll
  for (int r = 0; r < 16; ++r) ps += p0[r];
#pragma unroll
  for (int r = 0; r < 16; ++r) ps += p1[r];
  { auto rr = __builtin_amdgcn_permlane32_swap(__float_as_uint(ps), __float_as_uint(ps), false, false);
    ps = __uint_as_float(rr[0]) + __uint_as_float(rr[1]); }
  l_reg = l_reg * alpha + ps;
#define PK4(P, BASE, OUT) do { unsigned a0 = cvtpk(P[BASE + 0], P[BASE + 1]), a1 = cvtpk(P[BASE + 2], P[BASE + 3]);   \
    unsigned b0 = cvtpk(P[BASE + 4], P[BASE + 5]), b1 = cvtpk(P[BASE + 6], P[BASE + 7]);                              \
    auto r0 = __builtin_amdgcn_permlane32_swap(a0, b0, false, false); auto r1 = __builtin_amdgcn_permlane32_swap(a1, b1, false, false); \
    u32x4 w = {r0[0], r1[0], r0[1], r1[1]}; OUT = *reinterpret_cast<bf16x8*>(&w); } while (0)
  PK4(p0, 0, pa0); PK4(p0, 8, pa1); PK4(p1, 0, pa2); PK4(p1, 8, pa3);
#undef PK4
}
template <int DQK> __device__ __forceinline__ int kswz(int row, int colB) { return row * (DQK * 2) + (colB ^ ((row & 7) << 4)); }
template <int DQK>
__device__ __forceinline__ void qkt(f32x16& p0, f32x16& p1, const char* Ks, const bf16x8* qr, int r32, int hi) {
  p0 = f32x16{}; p1 = f32x16{};
#pragma unroll
  for (int d0 = 0; d0 < DQK / 16; ++d0) { int cb = (d0 * 16 + hi * 8) * 2;
    bf16x8 b0 = *reinterpret_cast<const bf16x8*>(Ks + kswz<DQK>(r32, cb));
    bf16x8 b1 = *reinterpret_cast<const bf16x8*>(Ks + kswz<DQK>(32 + r32, cb));
    p0 = __builtin_amdgcn_mfma_f32_32x32x16_bf16(b0, qr[d0], p0, 0, 0, 0);
    p1 = __builtin_amdgcn_mfma_f32_32x32x16_bf16(b1, qr[d0], p1, 0, 0, 0); }
}
__device__ __forceinline__ int v_st(int k, int c) { const int kk = (k & ~0xC) | ((k & 4) << 1) | ((k & 8) >> 1); return ((kk >> 3) * 4 + (c >> 5)) * 512 + ((kk & 7) * 32 + (c & 31)) * 2; }
__device__ __forceinline__ int v_rd_base(int lane) { return ((lane & 3) << 3) | (((lane >> 2) & 3) << 6) | (((lane >> 4) & 1) << 5) | (((lane >> 5) & 1) << 8); }
constexpr int v_rd_off(int d0, int ks, int half) { return d0 * 512 + ks * 4096 + half * 2048; }
template <int OFF> __device__ __forceinline__ s16x4 tr_read(int vb) {
  s16x4 r; asm volatile("ds_read_b64_tr_b16 %0, %1 offset:%2" : "=&v"(r) : "v"(vb), "i"(OFF) : "memory"); return r;
}
template <int D0> __device__ __forceinline__ void pv_one(f32x16& od, int vb, bf16x8 pa0, bf16x8 pa1, bf16x8 pa2, bf16x8 pa3) {
  const s16x4 l0 = tr_read<v_rd_off(D0, 0, 0)>(vb), h0 = tr_read<v_rd_off(D0, 0, 1)>(vb), l1 = tr_read<v_rd_off(D0, 1, 0)>(vb), h1 = tr_read<v_rd_off(D0, 1, 1)>(vb);
  const s16x4 l2 = tr_read<v_rd_off(D0, 2, 0)>(vb), h2 = tr_read<v_rd_off(D0, 2, 1)>(vb), l3 = tr_read<v_rd_off(D0, 3, 0)>(vb), h3 = tr_read<v_rd_off(D0, 3, 1)>(vb);
  asm volatile("s_waitcnt lgkmcnt(0)" ::: "memory"); SBAR();
#define PK(L, H) (bf16x8){L[0], L[1], L[2], L[3], H[0], H[1], H[2], H[3]}
  od = __builtin_amdgcn_mfma_f32_32x32x16_bf16(pa0, PK(l0, h0), od, 0, 0, 0);
  od = __builtin_amdgcn_mfma_f32_32x32x16_bf16(pa1, PK(l1, h1), od, 0, 0, 0);
  od = __builtin_amdgcn_mfma_f32_32x32x16_bf16(pa2, PK(l2, h2), od, 0, 0, 0);
  od = __builtin_amdgcn_mfma_f32_32x32x16_bf16(pa3, PK(l3, h3), od, 0, 0, 0);
#undef PK
}
__device__ __forceinline__ void pv_d0(f32x16* o, int vb, bf16x8 pa0, bf16x8 pa1, bf16x8 pa2, bf16x8 pa3) {
  pv_one<0>(o[0], vb, pa0, pa1, pa2, pa3); pv_one<1>(o[1], vb, pa0, pa1, pa2, pa3); pv_one<2>(o[2], vb, pa0, pa1, pa2, pa3); pv_one<3>(o[3], vb, pa0, pa1, pa2, pa3);
}
__device__ __forceinline__ void rope8(bf16x8& a, bf16x8& b, const float* cs, const float* sn) {
  const f32x4 c0 = *(const f32x4*)cs, c1 = *(const f32x4*)(cs + 4), s0 = *(const f32x4*)sn, s1 = *(const f32x4*)(sn + 4);
  float x1[8], x2[8], y1[8], y2[8];
#pragma unroll
  for (int e = 0; e < 8; ++e) { x1[e] = __uint_as_float(((unsigned)(unsigned short)a[e]) << 16); x2[e] = __uint_as_float(((unsigned)(unsigned short)b[e]) << 16); }
#pragma unroll
  for (int e = 0; e < 8; ++e) { const float c = e < 4 ? c0[e & 3] : c1[e & 3], s = e < 4 ? s0[e & 3] : s1[e & 3]; y1[e] = x1[e] * c - x2[e] * s; y2[e] = x2[e] * c + x1[e] * s; }
  u32x4 wa = {cvtpk(y1[0], y1[1]), cvtpk(y1[2], y1[3]), cvtpk(y1[4], y1[5]), cvtpk(y1[6], y1[7])};
  u32x4 wb = {cvtpk(y2[0], y2[1]), cvtpk(y2[2], y2[3]), cvtpk(y2[4], y2[5]), cvtpk(y2[6], y2[7])};
  a = *reinterpret_cast<bf16x8*>(&wa); b = *reinterpret_cast<bf16x8*>(&wb);
}
template <int DQK, int LDQ, int LDK, int LDV>
__device__ __forceinline__ void attn_body(const bf16* __restrict__ Qb, const bf16* __restrict__ Kh, const bf16* __restrict__ Kr, const bf16* __restrict__ Vh,
                                          bf16* __restrict__ Ob, int seq, char* lds, const float C, const float THRS, const float* cosq, const float* sinq) {
  constexpr int ND = DQK / 16; constexpr size_t SHM_K = KVBLK * DQK * 2; constexpr int LDO = 2048; constexpr bool X = (DQK == 192);
  const int tid = threadIdx.x, wid = tid >> 6, lane = tid & 63, r32 = lane & 31, hi = lane >> 5;
  char* V_lds = lds; char* K_lds = lds + 2 * SHM_V;
  float* ws = (float*)(lds + 2 * SHM_V + 2 * SHM_K) + wid * 64; float* li_l = ws; float* al_l = ws + 32;
  float m_reg = -1e30f, l_reg = 0; f32x16 o[4] = {}; bf16x8 qr[ND];
  const bf16* Qw = Qb + (long)(wid * QBLK + r32) * LDQ + hi * 8;
#pragma unroll
  for (int d0 = 0; d0 < ND; ++d0) qr[d0] = *reinterpret_cast<const bf16x8*>(Qw + d0 * 16);
  if constexpr (X) { if (cosq) { const float* cs = cosq + (wid * QBLK + r32) * 32 + hi * 8; const float* sn = sinq + (wid * QBLK + r32) * 32 + hi * 8;
      rope8(qr[8], qr[10], cs, sn); rope8(qr[9], qr[11], cs + 16, sn + 16); } }
  const int sr = tid >> 4, sc = (tid & 15) * 8, vst0 = v_st(sr, sc), vst1 = v_st(32 + sr, sc);
  const int xr = tid >> 3, xc = (tid & 7) * 8;
  const int vb0 = (int)(uintptr_t)V_lds + v_rd_base(lane);
  bf16x8 s_vs0, s_vs1, s_ks0, s_ks1, s_kx;
#define SLOAD(k0) do { s_vs0 = *(const bf16x8*)(&Vh[(long)((k0) + sr) * LDV + sc]); s_vs1 = *(const bf16x8*)(&Vh[(long)((k0) + 32 + sr) * LDV + sc]); \
    s_ks0 = *(const bf16x8*)(&Kh[(long)((k0) + sr) * LDK + sc]); s_ks1 = *(const bf16x8*)(&Kh[(long)((k0) + 32 + sr) * LDK + sc]); \
    if constexpr (X) s_kx = *(const bf16x8*)(&Kr[(long)((k0) + xr) * 64 + xc]); } while (0)
#define SWRITE(b) do { *(bf16x8*)(V_lds + (b) * SHM_V + vst0) = s_vs0;          \
    *(bf16x8*)(V_lds + (b) * SHM_V + vst1) = s_vs1; int kc = sc * 2;               \
    *(bf16x8*)(K_lds + (b) * SHM_K + kswz<DQK>(sr, kc)) = s_ks0;                       \
    *(bf16x8*)(K_lds + (b) * SHM_K + kswz<DQK>(32 + sr, kc)) = s_ks1; \
    if constexpr (X) *(bf16x8*)(K_lds + (b) * SHM_K + kswz<DQK>(xr, 256 + xc * 2)) = s_kx; } while (0)
#define RESC(a) do { if (__any((a) < 1.f)) { if (hi == 0) al_l[r32] = (a); asm volatile("s_waitcnt lgkmcnt(0)" ::: "memory"); \
    _Pragma("unroll") for (int d = 0; d < 4; ++d) _Pragma("unroll") for (int r = 0; r < 16; ++r) o[d][r] *= al_l[crow(r, hi)]; } } while (0)
#define TILE(b) do { f32x16 p0, p1; float mn, al; bf16x8 pa0, pa1, pa2, pa3; \
    qkt<DQK>(p0, p1, K_lds + (b) * SHM_K, qr, r32, hi); partialSM(p0, p1, m_reg, mn, al, C, THRS); RESC(al); \
    finishSM(p0, p1, al, l_reg, pa0, pa1, pa2, pa3); SBAR(); pv_d0(o, vb0 + (b) * (int)SHM_V, pa0, pa1, pa2, pa3); } while (0)
  const int NT = seq / KVBLK;
  SLOAD(0); asm volatile("s_waitcnt vmcnt(0)" ::: "memory"); SWRITE(0); SLOAD(KVBLK); __syncthreads();
  for (int j = 0; j < NT; j += 2) {
    SWRITE(1); if (j + 2 < NT) SLOAD((j + 2) * KVBLK);
    TILE(0);
    __syncthreads();
    if (j + 2 < NT) { SWRITE(0); if (j + 3 < NT) SLOAD((j + 3) * KVBLK); }
    TILE(1);
    __syncthreads();
  }
  if (hi == 0) li_l[r32] = l_reg; asm volatile("s_waitcnt lgkmcnt(0)" ::: "memory");
  float rli[16];
#pragma unroll
  for (int r = 0; r < 16; ++r) rli[r] = __builtin_amdgcn_rcpf(li_l[crow(r, hi)]);
  bf16* Ow = Ob + (long)(wid * QBLK) * LDO;
#pragma unroll
  for (int r = 0; r < 16; ++r) { int orow = crow(r, hi);
#pragma unroll
    for (int d0 = 0; d0 < 4; ++d0) Ow[(long)orow * LDO + d0 * 32 + r32] = f2bf(o[d0][r] * rli[r]); }
#undef SLOAD
#undef SWRITE
#undef TILE
#undef RESC
}
}
struct Params { const float* in[30]; float* out; unsigned char* ws; };
enum { I_X = 0, I_C, I_CTX, I_CCTX, I_MODW, I_MODB, I_NMIX, I_NFFN, I_WMIX, I_WG, I_WU, I_WD, I_WATT, I_QNW, I_KNW, I_MQNW, I_WUQ, I_MKVNW, I_WUKV, I_WREC,
       I_CONVW, I_CONVB, I_RAW, I_RAB, I_IXW, I_IXB, I_LAM, I_LBL, I_HGNW, I_FNW };

__device__ __forceinline__ void tr_item(const float* W, int N, bf16* WT, int ldt, int koff, int drow0, LAS float* scr, int k0, int n0, int lane) {
#pragma unroll 8
    for (int i = 0; i < 32; ++i) { const int kk = 2 * i + (lane >> 5); scr[kk * 33 + (lane & 31)] = W[(size_t)(k0 + kk) * N + n0 + (lane & 31)]; }
    LDS_WAIT();
    const int c = lane & 7;
#pragma unroll
    for (int j = 0; j < 4; ++j) { const int n = (lane >> 3) + 8 * j; const LAS float* s = scr + (8 * c) * 33 + n;
        v4u o; o.x = cvtpk(s[0 * 33], s[1 * 33]); o.y = cvtpk(s[2 * 33], s[3 * 33]); o.z = cvtpk(s[4 * 33], s[5 * 33]); o.w = cvtpk(s[6 * 33], s[7 * 33]);
        *(v4u*)(WT + (size_t)(drow0 + n) * ldt + koff + k0 + 8 * c) = o; }
    LDS_WAIT();
}
template <int MODE>
__device__ __forceinline__ void tr_job(const float* W, int K, int N, bf16* WT, int row_off, int& base, int gw, int NGW, LAS float* scr, int lane) {
    const int nblk = N / 32, nit = (K / 64) * nblk;
    int it = (gw - base % NGW + NGW) % NGW;
    for (; it < nit; it += NGW) { const int kb = it / nblk, n0 = (it % nblk) * 32;
        const int drow0 = MODE ? (n0 >> 7) * 256 + row_off + (n0 & 127) : row_off + n0;
        tr_item(W, N, WT, K, 0, drow0, scr, kb * 64, n0, lane); }
    base += nit;
}
__device__ __forceinline__ void sincos_(float x, float& s, float& c) {
    const float k = rintf(x * 0.15915494309189535f); float r = fmaf(-k, 6.2831854820251465f, x); r = fmaf(-k, -1.7484555e-7f, r);
    s = __sinf(r); c = __cosf(r);
}
__device__ __forceinline__ void phase0(const Params& P, LAS unsigned char* lds) {
    const int tid = threadIdx.x, lane = tid & 63, wave = tid >> 6, G = gridDim.x, bid = blockIdx.x;
    unsigned char* ws = P.ws;
    {
        LAS float* sv = (LAS float*)lds;
        LAS float* red = (LAS float*)(lds + 40960);
        for (int i = tid; i < 5 * 2048; i += 512) { const int j = i >> 11, k = i & 2047; const float v = j < 4 ? P.in[I_C][j * 2048 + k] : P.in[I_CCTX][k]; sv[i] = siluf_(v); }
        __syncthreads();
        float* mod = (float*)(ws + WS_MOD);
        for (int task = bid; task < 192; task += G) {
            const int l = task / 96, n0 = (task % 96) * 128, tc = tid & 31, kg = tid >> 5;
            const float* Wp = P.in[I_MODW] + (size_t)l * 2048 * MODW + n0 + tc * 4;
            f32x4 acc[5];
#pragma unroll
            for (int j = 0; j < 5; ++j) acc[j] = (f32x4){0.f, 0.f, 0.f, 0.f};
#pragma unroll 4
            for (int k = kg; k < 2048; k += 16) { const f32x4 w = *(const f32x4*)(Wp + (size_t)k * MODW);
#pragma unroll
                for (int j = 0; j < 5; ++j) acc[j] += w * sv[j * 2048 + k]; }
#pragma unroll
            for (int j = 0; j < 5; ++j)
#pragma unroll
                for (int e = 0; e < 4; ++e) red[(kg * 32 + tc) * 20 + j * 4 + e] = acc[j][e];
            __syncthreads();
            for (int o = tid; o < 640; o += 512) { const int j = o >> 7, c = o & 127; float s = 0.f;
#pragma unroll
                for (int g = 0; g < 16; ++g) s += red[(g * 32 + (c >> 2)) * 20 + j * 4 + (c & 3)];
                mod[((size_t)l * 5 + j) * MODW + n0 + c] = s + P.in[I_MODB][l * MODW + n0 + c]; }
            __syncthreads();
        }
    }
    {
        const int gid = bid * 512 + tid, GT = G * 512;
        float* cosA = (float*)(ws + WS_COSA); float* sinA = (float*)(ws + WS_SINA); float* cosB = (float*)(ws + WS_COSB); float* sinB = (float*)(ws + WS_SINB);
        for (int i = gid; i < 4096 * 64; i += GT) { const int pos = i >> 6, k = i & 63, j = k & 31; const float p = (k < 32) ? (float)(pos >> 6) : (float)(pos & 63);
            const float f = expf(-(float)j * (9.210340371976184f / 32.f)); float s, c; sincos_(p * f, s, c); cosA[i] = c; sinA[i] = s; }
        for (int i = gid; i < 4096 * 32; i += GT) { const int pos = i >> 5, k = i & 31, j = k & 15; const float p = (k < 16) ? (float)(pos >> 6) : (float)(pos & 63);
            const float f = expf(-(float)j * (9.210340371976184f / 16.f)); float s, c; sincos_(p * f, s, c); cosB[i] = c; sinB[i] = s; }
        float* lb = (float*)(ws + WS_LB); float* sp8 = (float*)(ws + WS_SP8);
        for (int i = gid; i < 2048; i += GT) { const int d = i >> 10, w = i & 1023; const float l0 = P.in[I_LBL][(d * 2 + 0) * 1024 + w], l1 = P.in[I_LBL][(d * 2 + 1) * 1024 + w];
            lb[i] = 1.f / (1.f + expf(l0 - l1));
            const float e = expf(-P.in[I_LAM][i]); sp8[i] = 8.f * log1pf(e); }
        bf16* Wl = (bf16*)(ws + WS_WLRU);
        for (int i = gid; i < 65536; i += GT) { const int row = i >> 4, ch = i & 15, pn = row >> 8, nn = (pn >> 1) & 1;
            *(v4u*)(Wl + (size_t)row * 256 + (1 - nn) * 128 + ch * 8) = (v4u){0u, 0u, 0u, 0u}; }
    }
    {
        LAS float* scr = (LAS float*)(lds + wave * 16384);
        const int gw = bid * 8 + wave, NGW = G * 8; int base = 0;
        tr_job<0>(P.in[I_WATT], 2048, AIW, (bf16*)(ws + WS_WATT), 0, base, gw, NGW, scr, lane);
        tr_job<0>(P.in[I_WUQ], 512, 1536, (bf16*)(ws + WS_WUQ), 0, base, gw, NGW, scr, lane);
        tr_job<0>(P.in[I_WUKV], 512, 2048, (bf16*)(ws + WS_WUKV), 0, base, gw, NGW, scr, lane);
        tr_job<0>(P.in[I_WMIX], 2048, 2048, (bf16*)(ws + WS_WMIX0), 0, base, gw, NGW, scr, lane);
        tr_job<0>(P.in[I_WMIX] + (size_t)2048 * 2048, 2048, 2048, (bf16*)(ws + WS_WMIX1), 0, base, gw, NGW, scr, lane);
        tr_job<1>(P.in[I_WG], 2048, FFH, (bf16*)(ws + WS_WGU0), 0, base, gw, NGW, scr, lane);
        tr_job<1>(P.in[I_WU], 2048, FFH, (bf16*)(ws + WS_WGU0), 128, base, gw, NGW, scr, lane);
        tr_job<1>(P.in[I_WG] + (size_t)2048 * FFH, 2048, FFH, (bf16*)(ws + WS_WGU1), 0, base, gw, NGW, scr, lane);
        tr_job<1>(P.in[I_WU] + (size_t)2048 * FFH, 2048, FFH, (bf16*)(ws + WS_WGU1), 128, base, gw, NGW, scr, lane);
        tr_job<0>(P.in[I_WD], FFH, 2048, (bf16*)(ws + WS_WD0), 0, base, gw, NGW, scr, lane);
        tr_job<0>(P.in[I_WD] + (size_t)FFH * 2048, FFH, 2048, (bf16*)(ws + WS_WD1), 0, base, gw, NGW, scr, lane);
        tr_job<0>(P.in[I_WREC], 2048, RIW, (bf16*)(ws + WS_WREC), 0, base, gw, NGW, scr, lane);
        {
            int it = (gw - base % NGW + NGW) % NGW;
            for (; it < 256; it += NGW) { const int which = it >> 7, rem = it & 127, d = rem >> 6, n = (rem >> 3) & 7, sub = rem & 7, kb = sub >> 2, nbk = sub & 3;
                const float* W = (which ? P.in[I_IXW] : P.in[I_RAW]) + (size_t)(d * 8 + n) * 128 * 128;
                const int pn = (n >> 1) * 4 + (n & 1) * 2 + d;
                tr_item(W, 128, (bf16*)(ws + WS_WLRU), 256, (n & 1) * 128, pn * 256 + which * 128 + nbk * 32, scr, kb * 64, nbk * 32, lane); }
        }
    }
}

template <int MODE>
__device__ __forceinline__ void norm_phase(const Params& P, const float* nw, const float* mod_sh  , bool lat_only) {
    const int tid = threadIdx.x, lane = tid & 63, wave = tid >> 6, gw = blockIdx.x * 8 + wave, NGW = gridDim.x * 8;
    float* H = (float*)(P.ws + WS_H); bf16* U = (bf16*)(P.ws + WS_U);
    f32x4 w4[8];
#pragma unroll
    for (int j = 0; j < 8; ++j) w4[j] = ((const f32x4*)nw)[lane + 64 * j];
    for (int r = gw; r < MT; r += NGW) {
        const int b = r / TPB, tb = r - b * TPB; const bool isctx = tb < CTXL;
        if ((lat_only || MODE == 2) && isctx) continue;
        const float* src;
        if (MODE == 0) src = isctx ? P.in[I_CTX] + (size_t)(b * CTXL + tb) * DM : P.in[I_X] + (size_t)(b * SEQL + tb - CTXL) * DM;
        else src = H + (size_t)r * DM;
        f32x4 v[8]; float s = 0.f;
#pragma unroll
        for (int j = 0; j < 8; ++j) { v[j] = ((const f32x4*)src)[lane + 64 * j]; s += (v[j].x * v[j].x + v[j].y * v[j].y) + (v[j].z * v[j].z + v[j].w * v[j].w); }
        if (MODE == 0) {
#pragma unroll
            for (int j = 0; j < 8; ++j) ((f32x4*)(H + (size_t)r * DM))[lane + 64 * j] = v[j]; }
        const float rstd = rsqrtf(wave_sum(s) * (1.f / DM) + EPS);
        if (MODE == 2) {
            float* o = P.out + (size_t)(b * SEQL + tb - CTXL) * DM;
#pragma unroll
            for (int j = 0; j < 8; ++j) ((f32x4*)o)[lane + 64 * j] = v[j] * rstd * w4[j];
        } else {
            const float* sh = mod_sh + (size_t)(isctx ? 4 : b) * MODW; const float* sc = sh + DM;
#pragma unroll
            for (int j = 0; j < 8; ++j) { const f32x4 a = ((const f32x4*)sh)[lane + 64 * j], m = ((const f32x4*)sc)[lane + 64 * j];
                const f32x4 y = (v[j] * rstd * w4[j]) * (m + 1.f) + a;
                ((v2u*)(U + (size_t)r * DM))[lane + 64 * j] = (v2u){cvtpk(y.x, y.y), cvtpk(y.z, y.w)}; }
        }
    }
}
__device__ __forceinline__ void attn_post_phase(const Params& P) {
    const int tid = threadIdx.x, lane = tid & 63, wave = tid >> 6, gw = blockIdx.x * 8 + wave, NGW = gridDim.x * 8;
    unsigned char* ws = P.ws;
    const bf16* proj = (const bf16*)(ws + WS_PROJ); bf16* Qa = (bf16*)(ws + WS_QA); bf16* Ka = (bf16*)(ws + WS_KA);
    bf16* cqn = (bf16*)(ws + WS_CQN); bf16* ckvn = (bf16*)(ws + WS_CKVN); bf16* kr = (bf16*)(ws + WS_KR);
    const float* cosA = (const float*)(ws + WS_COSA); const float* sinA = (const float*)(ws + WS_SINA);
    const float* cosB = (const float*)(ws + WS_COSB); const float* sinB = (const float*)(ws + WS_SINB);
    const int hl = lane >> 5, l32 = lane & 31;
    for (int r = gw; r < MT; r += NGW) {
        const int b = r / TPB, tb = r - b * TPB; const bool lat = tb >= CTXL; const int pos = tb - CTXL;
        const bf16* pr = proj + (size_t)r * AIWP;
#pragma unroll
        for (int it = 0; it < 5; ++it) {
            const int hh = it * 2 + hl;
            const unsigned wa = *(const unsigned*)(pr + hh * 128 + 2 * l32), wb = *(const unsigned*)(pr + hh * 128 + 64 + 2 * l32);
            float a0 = bflo(wa), a1 = bfhi(wa), b0 = bflo(wb), b1 = bfhi(wb);
            float ss = a0 * a0 + a1 * a1 + b0 * b0 + b1 * b1;
#pragma unroll
            for (int o = 1; o < 32; o <<= 1) ss += __shfl_xor(ss, o);
            const float rstd = rsqrtf(ss * (1.f / 128.f) + EPS);
            const float* nw = (hh < 8) ? P.in[I_QNW] : P.in[I_KNW];
            a0 *= rstd * nw[2 * l32]; a1 *= rstd * nw[2 * l32 + 1]; b0 *= rstd * nw[64 + 2 * l32]; b1 *= rstd * nw[64 + 2 * l32 + 1];
            if (lat) { const float c0 = cosA[pos * 64 + 2 * l32], c1 = cosA[pos * 64 + 2 * l32 + 1], s0 = sinA[pos * 64 + 2 * l32], s1 = sinA[pos * 64 + 2 * l32 + 1];
                const float x0 = a0 * c0 - b0 * s0, x1 = a1 * c1 - b1 * s1, y0 = b0 * c0 + a0 * s0, y1 = b1 * c1 + a1 * s1; a0 = x0; a1 = x1; b0 = y0; b1 = y1; }
            bf16* dst = (hh < 8) ? Qa + (size_t)r * 1024 + hh * 128 : Ka + (size_t)r * 256 + (hh - 8) * 128;
            *(unsigned*)(dst + 2 * l32) = cvtpk(a0, a1); *(unsigned*)(dst + 64 + 2 * l32) = cvtpk(b0, b1);
        }
#pragma unroll
        for (int which = 0; which < 2; ++which) {
            const v4u x = *(const v4u*)(pr + 1536 + which * 512 + lane * 8);
            float f[8]; float ss = 0.f;
#pragma unroll
            for (int e = 0; e < 4; ++e) { f[2 * e] = bflo(x[e]); f[2 * e + 1] = bfhi(x[e]); ss += f[2 * e] * f[2 * e] + f[2 * e + 1] * f[2 * e + 1]; }
            const float rstd = rsqrtf(wave_sum(ss) * (1.f / 512.f) + EPS);
            const float* nw = (which ? P.in[I_MKVNW] : P.in[I_MQNW]) + lane * 8;
            v4u o;
#pragma unroll
            for (int e = 0; e < 4; ++e) o[e] = cvtpk(f[2 * e] * rstd * nw[2 * e], f[2 * e + 1] * rstd * nw[2 * e + 1]);
            *(v4u*)((which ? ckvn : cqn) + (size_t)r * 512 + lane * 8) = o;
        }
        if (lane < 32) {
            float x1 = bf2f(pr[2560 + lane]), x2 = bf2f(pr[2592 + lane]);
            if (lat) { const float c = cosB[pos * 32 + lane], s = sinB[pos * 32 + lane]; const float y1 = x1 * c - x2 * s, y2 = x2 * c + x1 * s; x1 = y1; x2 = y2; }
            kr[(size_t)r * 64 + lane] = f2bf(x1); kr[(size_t)r * 64 + 32 + lane] = f2bf(x2);
        }
    }
}

__device__ __forceinline__ void attn_phase(const Params& P, char* lds) {
    unsigned char* ws = P.ws;
    const bf16* proj = (const bf16*)(ws + WS_PROJ); const bf16* Qa = (const bf16*)(ws + WS_QA); const bf16* Ka = (const bf16*)(ws + WS_KA);
    const bf16* kr = (const bf16*)(ws + WS_KR); const bf16* qb = (const bf16*)(ws + WS_QB); const bf16* kvb = (const bf16*)(ws + WS_KVB);
    bf16* mix = (bf16*)(ws + WS_MIX);
    const float* cosB = (const float*)(ws + WS_COSB); const float* sinB = (const float*)(ws + WS_SINB);
    const int w = blockIdx.x, G = gridDim.x;
    const float CA = 0.08838834764831845f * 1.4426950408889634f, TA = 8.f / 0.08838834764831845f;
    const float CB = 0.07216878364870323f * 1.4426950408889634f, TB = 8.f / 0.07216878364870323f;
    for (int u = w; u < 512 + 32; u += G) {
        __syncthreads();
        int b, h, qblk; bool isctx = false;
        if (u < 512) { const int r = u >> 8, ww = u & 255, grp = r * 4 + ((ww & 7) >> 1), idx = ((ww & 7) & 1) * 32 + (ww >> 3);
            b = grp >> 1; h = (grp & 1) * 4 + (idx >> 4); qblk = idx & 15; }
        else { const int v = u - 512; b = v >> 3; h = v & 7; qblk = 0; isctx = true; }
        const size_t row0 = (size_t)b * TPB, qrow = isctx ? row0 : row0 + CTXL + qblk * 256; const int seq = isctx ? CTXL : TPB;
        const int kvh = h >> 2;
        attn::attn_body<128, 1024, 256, AIWP>(Qa + qrow * 1024 + h * 128, Ka + row0 * 256 + kvh * 128, nullptr, proj + row0 * AIWP + 1280 + kvh * 128,
                                              mix + qrow * 2048 + h * 128, seq, lds, CA, TA, nullptr, nullptr);
    }
    for (int u0 = w; u0 < 512 + 256; u0 += G) {
        int u = u0; if (u0 >= 512) { if (u0 < 512 + 32 || u0 >= 512 + 64) continue; u = u0 - 32; }
        __syncthreads();
        int b, h, qblk; bool isctx = false;
        if (u < 512) { const int r = u >> 8, ww = u & 255, grp = r * 16 + (ww & 7) * 2 + ((ww >> 3) >> 4);
            b = grp >> 3; h = grp & 7; qblk = (ww >> 3) & 15; }
        else { const int v = u - 512; b = v >> 3; h = v & 7; qblk = 0; isctx = true; }
        const size_t row0 = (size_t)b * TPB, qrow = isctx ? row0 : row0 + CTXL + qblk * 256; const int seq = isctx ? CTXL : TPB;
        attn::attn_body<192, 1536, 2048, 2048>(qb + qrow * 1536 + h * 192, kvb + row0 * 2048 + h * 256, kr + row0 * 64, kvb + row0 * 2048 + h * 256 + 128,
                                               mix + qrow * 2048 + 1024 + h * 128, seq, lds, CB, TB, isctx ? nullptr : cosB + (size_t)qblk * 256 * 32, isctx ? nullptr : sinB + (size_t)qblk * 256 * 32);
    }
}

__device__ __forceinline__ void conv_phase(const Params& P) {
    const bf16* prec = (const bf16*)(P.ws + WS_PREC); bf16* xc = (bf16*)(P.ws + WS_XC);
    const float* cw = P.in[I_CONVW]; const float* cb = P.in[I_CONVB];
    const int GT = gridDim.x * 512;
    for (int idx = blockIdx.x * 512 + threadIdx.x; idx < MT * 128; idx += GT) {
        const int row = idx >> 7, c8 = (idx & 127) * 8, tb = row % TPB, lo = tb < CTXL ? 0 : CTXL, hi = tb < CTXL ? CTXL : TPB;
        float acc[8];
#pragma unroll
        for (int e = 0; e < 8; ++e) acc[e] = cb[c8 + e];
#pragma unroll
        for (int j = 0; j < 4; ++j) { const int t2 = tb + j - 2;
            if (t2 >= lo && t2 < hi) { const v4u x = *(const v4u*)(prec + (size_t)(row + j - 2) * RIW + c8);
#pragma unroll
                for (int e = 0; e < 4; ++e) { acc[2 * e] += cw[j * 1024 + c8 + 2 * e] * bflo(x[e]); acc[2 * e + 1] += cw[j * 1024 + c8 + 2 * e + 1] * bfhi(x[e]); } } }
        *(v4u*)(xc + (size_t)row * 1024 + c8) = (v4u){cvtpk(acc[0], acc[1]), cvtpk(acc[2], acc[3]), cvtpk(acc[4], acc[5]), cvtpk(acc[6], acc[7])};
    }
}
typedef float f32x4m __attribute__((ext_vector_type(4)));
__device__ __forceinline__ void hg_a_phase(const Params& P, LAS unsigned char* lds) {
    const bf16* prec = (const bf16*)(P.ws + WS_PREC); bf16* SS = (bf16*)(P.ws + WS_SS); float* HGD = (float*)(P.ws + WS_HGD); const float* lb = (const float*)(P.ws + WS_LB);
    LAS bf16* Kt = (LAS bf16*)lds;
    LAS bf16* Vt = (LAS bf16*)(lds + 36864);
    const int tid = threadIdx.x, lane = tid & 63, wid = tid >> 6, fr = lane & 15, fq = lane >> 4;
    for (int task = blockIdx.x; task < NBATCH * 8 * 68; task += gridDim.x) {
        const int rc = task % 68, bh = task / 68, b = bh >> 3, h = bh & 7; const size_t R0 = (size_t)b * TPB + rc * 64;
        __syncthreads();
#pragma unroll
        for (int i = 0; i < 2; ++i) { const int id = tid + 512 * i, r = id >> 4, v8 = (id & 15) * 8; const v4u x = *(const v4u*)(prec + (R0 + r) * RIW + 5120 + h * 128 + v8);
#pragma unroll
            for (int e = 0; e < 4; ++e) { Vt[(v8 + 2 * e) * 72 + r] = (bf16)(x[e] & 0xffffu); Vt[(v8 + 2 * e + 1) * 72 + r] = (bf16)(x[e] >> 16); } }
        if (tid < 256) {
            const int dir = tid >> 7, d = tid & 127; const float lbv = lb[dir * 1024 + h * 128 + d]; float E = 0.f;
            const bf16* pf = prec + R0 * RIW + 3072 + dir * 1024 + h * 128 + d;
            for (int i0 = 0; i0 < 64; i0 += 16) {
                float x[16];
#pragma unroll
                for (int e = 0; e < 16; ++e) { const int r = dir ? (i0 + e) : (63 - i0 - e); x[e] = bf2f(pf[(size_t)r * RIW]); }
#pragma unroll
                for (int e = 0; e < 16; ++e) { const int r = dir ? (i0 + e) : (63 - i0 - e);
                    const float sg = sigmoidf_(x[e]), f = lbv + (1.f - lbv) * sg, kk = (1.f - lbv) * (1.f - sg);
                    Kt[(dir * 128 + d) * 72 + r] = f2bf(kk * __expf(E)); E += __logf(f); }
            }
            HGD[((size_t)(bh * 2 + dir) * 68 + rc) * 128 + d] = __expf(E);
        }
        __syncthreads();
        const int dir = wid >> 2, dt0 = (wid & 3) * 2;
        bf16x8 a[2][2];
#pragma unroll
        for (int t = 0; t < 2; ++t)
#pragma unroll
            for (int ks = 0; ks < 2; ++ks) a[t][ks] = *(const LAS bf16x8*)(Kt + (dir * 128 + (dt0 + t) * 16 + fr) * 72 + ks * 32 + fq * 8);
        bf16* out = SS + ((size_t)(bh * 2 + dir) * 68 + rc) * 16384;
#pragma unroll
        for (int vt = 0; vt < 8; ++vt) {
            bf16x8 bb[2];
#pragma unroll
            for (int ks = 0; ks < 2; ++ks) bb[ks] = *(const LAS bf16x8*)(Vt + (vt * 16 + fr) * 72 + ks * 32 + fq * 8);
#pragma unroll
            for (int t = 0; t < 2; ++t) { f32x4m c = {0.f, 0.f, 0.f, 0.f};
                c = __builtin_amdgcn_mfma_f32_16x16x32_bf16(a[t][0], bb[0], c, 0, 0, 0); c = __builtin_amdgcn_mfma_f32_16x16x32_bf16(a[t][1], bb[1], c, 0, 0, 0);
                *(v2u*)(out + (vt * 16 + fr) * 128 + (dt0 + t) * 16 + 4 * fq) = (v2u){cvtpk(c[0], c[1]), cvtpk(c[2], c[3])}; }
        }
    }
}
__device__ __forceinline__ void hg_b_phase(const Params& P) {
    bf16* SS = (bf16*)(P.ws + WS_SS); const float* HGD = (const float*)(P.ws + WS_HGD);
    const int GT = gridDim.x * 512;
    for (int t = blockIdx.x * 512 + threadIdx.x; t < 64 * 2048; t += GT) {
        const int seq = t >> 11, v = (t >> 4) & 127, d8 = (t & 15) * 8, dir = seq & 1;
        float S[8];
#pragma unroll
        for (int e = 0; e < 8; ++e) S[e] = 0.f;
        for (int j0 = 0; j0 < 68; j0 += 4) {
            v4u x[4]; f32x4 d0[4], d1[4]; bf16* p[4];
#pragma unroll
            for (int q = 0; q < 4; ++q) { const int j = j0 + q, rc = dir ? (j < 4 ? 3 - j : 71 - j) : j;
                p[q] = SS + ((size_t)seq * 68 + rc) * 16384 + v * 128 + d8; x[q] = *(const v4u*)p[q];
                const float* dp = HGD + ((size_t)seq * 68 + rc) * 128 + d8; d0[q] = *(const f32x4*)dp; d1[q] = *(const f32x4*)(dp + 4); }
#pragma unroll
            for (int q = 0; q < 4; ++q) {
                *(v4u*)p[q] = (v4u){cvtpk(S[0], S[1]), cvtpk(S[2], S[3]), cvtpk(S[4], S[5]), cvtpk(S[6], S[7])};
#pragma unroll
                for (int e = 0; e < 4; ++e) { S[2 * e] = (e < 2 ? d0[q][2 * e] : d1[q][2 * e - 4]) * S[2 * e] + bflo(x[q][e]); S[2 * e + 1] = (e < 2 ? d0[q][2 * e + 1] : d1[q][2 * e - 3]) * S[2 * e + 1] + bfhi(x[q][e]); }
            }
        }
    }
}
__device__ __forceinline__ void hg_c_phase(const Params& P, LAS unsigned char* lds) {
    const bf16* prec = (const bf16*)(P.ws + WS_PREC); const bf16* SS = (const bf16*)(P.ws + WS_SS); const float* lb = (const float*)(P.ws + WS_LB); bf16* mix = (bf16*)(P.ws + WS_MIX);
    LAS bf16* qs = (LAS bf16*)lds;
    LAS bf16* Vt = (LAS bf16*)(lds + 17408);
    LAS float* cum = (LAS float*)(lds + 35840);
    LAS bf16* ksm = (LAS bf16*)(lds + 69632);
    LAS float* red = (LAS float*)(lds + 105472);
    const int tid = threadIdx.x, lane = tid & 63, wid = tid >> 6, fr = lane & 15, fq = lane >> 4, ti = wid & 3, vh = wid >> 2;
    LAS bf16* Pw = (LAS bf16*)(lds + 87040) + wid * 1152;
    for (int task = blockIdx.x; task < NBATCH * 8 * 64; task += gridDim.x) {
        const int rc = 4 + (task & 63), bh = task >> 6, b = bh >> 3, h = bh & 7; const size_t R0 = (size_t)b * TPB + rc * 64;
        __syncthreads();
#pragma unroll
        for (int i = 0; i < 2; ++i) { const int id = tid + 512 * i, r = id >> 4, v8 = (id & 15) * 8;
            const v4u x = *(const v4u*)(prec + (R0 + r) * RIW + 5120 + h * 128 + v8);
#pragma unroll
            for (int e = 0; e < 4; ++e) { Vt[(v8 + 2 * e) * 72 + r] = (bf16)(x[e] & 0xffffu); Vt[(v8 + 2 * e + 1) * 72 + r] = (bf16)(x[e] >> 16); }
            const v4u q = *(const v4u*)(prec + (R0 + r) * RIW + 2048 + h * 128 + v8); v4u o;
#pragma unroll
            for (int e = 0; e < 4; ++e) o[e] = cvtpk(siluf_(bflo(q[e])), siluf_(bfhi(q[e])));
            *(LAS v4u*)(qs + r * 136 + v8) = o; }
        f32x4m oacc[4];
#pragma unroll
        for (int vt = 0; vt < 4; ++vt) oacc[vt] = (f32x4m){0.f, 0.f, 0.f, 0.f};
        for (int dir = 0; dir < 2; ++dir) {
            __syncthreads();
            if (tid < 128) {
                const int d = tid; const float lbv = lb[dir * 1024 + h * 128 + d]; float c = 0.f;
                const bf16* pf = prec + R0 * RIW + 3072 + dir * 1024 + h * 128 + d;
                for (int i0 = 0; i0 < 64; i0 += 16) {
                    float x[16];
#pragma unroll
                    for (int e = 0; e < 16; ++e) { const int r = dir ? (63 - i0 - e) : (i0 + e); x[e] = bf2f(pf[(size_t)r * RIW]); }
#pragma unroll
                    for (int e = 0; e < 16; ++e) { const int r = dir ? (63 - i0 - e) : (i0 + e);
                        const float sg = sigmoidf_(x[e]), f = lbv + (1.f - lbv) * sg, kk = (1.f - lbv) * (1.f - sg);
                        c += __logf(f); cum[r * 132 + d] = c; ksm[r * 136 + d] = f2bf(kk); }
                }
            }
            __syncthreads();
            const int refrow = dir ? 16 * (ti + 1) : 16 * ti - 1; const bool hasref = dir ? (ti < 3) : (ti > 0);
            bf16x8 Qt[4], Qh[4];
#pragma unroll
            for (int k4 = 0; k4 < 4; ++k4) { const int i = 16 * ti + fr, d = k4 * 32 + fq * 8;
                const v4u qw = *(const LAS v4u*)(qs + i * 136 + d);
                const f32x4 c0 = *(const LAS f32x4*)(cum + i * 132 + d), c1 = *(const LAS f32x4*)(cum + i * 132 + d + 4);
                f32x4 r0 = {0.f, 0.f, 0.f, 0.f}, r1 = {0.f, 0.f, 0.f, 0.f};
                if (hasref) { r0 = *(const LAS f32x4*)(cum + refrow * 132 + d); r1 = *(const LAS f32x4*)(cum + refrow * 132 + d + 4); }
                v4u wt, wh;
#pragma unroll
                for (int e = 0; e < 4; ++e) { const float qa = bflo(qw[e]), qb_ = bfhi(qw[e]);
                    const float ca = e < 2 ? c0[2 * e] : c1[2 * e - 4], cb_ = e < 2 ? c0[2 * e + 1] : c1[2 * e - 3];
                    const float ra = e < 2 ? r0[2 * e] : r1[2 * e - 4], rb = e < 2 ? r0[2 * e + 1] : r1[2 * e - 3];
                    wt[e] = cvtpk(qa * __expf(ca - ra), qb_ * __expf(cb_ - rb)); wh[e] = cvtpk(qa * __expf(ca), qb_ * __expf(cb_)); }
                Qt[k4] = *reinterpret_cast<bf16x8*>(&wt); Qh[k4] = *reinterpret_cast<bf16x8*>(&wh); }
#pragma unroll
            for (int sj = 0; sj < 4; ++sj) {
                const bool att = dir ? (sj >= ti) : (sj <= ti);
                f32x4m sc = {0.f, 0.f, 0.f, 0.f};
                if (att) {
#pragma unroll
                    for (int k4 = 0; k4 < 4; ++k4) { const int i2 = 16 * sj + fr, d = k4 * 32 + fq * 8;
                        const v4u kw = *(const LAS v4u*)(ksm + i2 * 136 + d);
                        const f32x4 c0 = *(const LAS f32x4*)(cum + i2 * 132 + d), c1 = *(const LAS f32x4*)(cum + i2 * 132 + d + 4);
                        f32x4 r0 = {0.f, 0.f, 0.f, 0.f}, r1 = {0.f, 0.f, 0.f, 0.f};
                        if (hasref) { r0 = *(const LAS f32x4*)(cum + refrow * 132 + d); r1 = *(const LAS f32x4*)(cum + refrow * 132 + d + 4); }
                        v4u wk;
#pragma unroll
                        for (int e = 0; e < 4; ++e) { const float ka = bflo(kw[e]), kb_ = bfhi(kw[e]);
                            const float ca = e < 2 ? c0[2 * e] : c1[2 * e - 4], cb_ = e < 2 ? c0[2 * e + 1] : c1[2 * e - 3];
                            const float ra = e < 2 ? r0[2 * e] : r1[2 * e - 4], rb = e < 2 ? r0[2 * e + 1] : r1[2 * e - 3];
                            wk[e] = cvtpk(ka * __expf(ra - ca), kb_ * __expf(rb - cb_)); }
                        sc = __builtin_amdgcn_mfma_f32_16x16x32_bf16(Qt[k4], *reinterpret_cast<bf16x8*>(&wk), sc, 0, 0, 0); }
                    if (sj == ti) {
#pragma unroll
                        for (int j = 0; j < 4; ++j) { const bool keep = dir ? (fr >= 4 * fq + j) : (fr <= 4 * fq + j); sc[j] = keep ? sc[j] : 0.f; } }
                }
#pragma unroll
                for (int j = 0; j < 4; ++j) Pw[(4 * fq + j) * 72 + 16 * sj + fr] = f2bf(sc[j]);
            }
            LDS_WAIT(); __builtin_amdgcn_wave_barrier();
#pragma unroll
            for (int ks = 0; ks < 2; ++ks) { const bf16x8 pa = *(const LAS bf16x8*)(Pw + fr * 72 + ks * 32 + fq * 8);
#pragma unroll
                for (int vt = 0; vt < 4; ++vt) { const bf16x8 vb = *(const LAS bf16x8*)(Vt + (vh * 64 + vt * 16 + fr) * 72 + ks * 32 + fq * 8);
                    oacc[vt] = __builtin_amdgcn_mfma_f32_16x16x32_bf16(pa, vb, oacc[vt], 0, 0, 0); } }
            const bf16* Sst = SS + ((size_t)(bh * 2 + dir) * 68 + rc) * 16384;
#pragma unroll
            for (int k4 = 0; k4 < 4; ++k4)
#pragma unroll
                for (int vt = 0; vt < 4; ++vt) { const bf16x8 sb = *(const bf16x8*)(Sst + (vh * 64 + vt * 16 + fr) * 128 + k4 * 32 + fq * 8);
                    oacc[vt] = __builtin_amdgcn_mfma_f32_16x16x32_bf16(Qh[k4], sb, oacc[vt], 0, 0, 0); }
        }
        float ssq[4];
#pragma unroll
        for (int j = 0; j < 4; ++j) { float s = 0.f;
#pragma unroll
            for (int vt = 0; vt < 4; ++vt) s += oacc[vt][j] * oacc[vt][j];
            s += __shfl_xor(s, 1); s += __shfl_xor(s, 2); s += __shfl_xor(s, 4); s += __shfl_xor(s, 8); ssq[j] = s; }
        if (fr == 0) {
#pragma unroll
            for (int j = 0; j < 4; ++j) red[(ti * 2 + vh) * 16 + 4 * fq + j] = ssq[j]; }
        __syncthreads();
#pragma unroll
        for (int j = 0; j < 4; ++j) { const int i = 16 * ti + 4 * fq + j;
            const float tot = red[(ti * 2) * 16 + 4 * fq + j] + red[(ti * 2 + 1) * 16 + 4 * fq + j]; const float rstd = rsqrtf(tot * (1.f / 128.f) + EPS);
#pragma unroll
            for (int vt = 0; vt < 4; ++vt) { const int v = vh * 64 + vt * 16 + fr;
                const float g = bf2f(prec[(R0 + i) * RIW + 6144 + h * 128 + v]);
                mix[(R0 + i) * 2048 + 1024 + h * 128 + v] = f2bf(oacc[vt][j] * rstd * P.in[I_HGNW][h * 128 + v] * siluf_(g)); } }
    }
}
__device__ __forceinline__ void lru_ab(float ra, float ix, float xc, float rab, float ixb, float sp, float& la, float& bb) {
    const float r = sigmoidf_(ra + rab), ig = sigmoidf_(ix + ixb); la = -r * sp; const float t = 2.f * la;
    const float em = (t > -0.02f) ? t * (1.f + t * (0.5f + t * (1.f / 6.f + t * (1.f / 24.f)))) : (__expf(t) - 1.f);
    bb = __builtin_amdgcn_sqrtf(-em) * (ig * xc);
}
__device__ __forceinline__ void lru_s1_phase(const Params& P) {
    const bf16* pre = (const bf16*)(P.ws + WS_LAB); const bf16* xcb = (const bf16*)(P.ws + WS_XC); float2* carr = (float2*)(P.ws + WS_CARR); const float* sp8 = (const float*)(P.ws + WS_SP8);
    const int GT = gridDim.x * 512;
    for (int t = blockIdx.x * 512 + threadIdx.x; t < NBATCH * 2 * 68 * 1024; t += GT) {
        const int ch = t & 1023, rc = (t >> 10) % 68, bd = (t >> 10) / 68, b = bd >> 1, dir = bd & 1, nb = ch >> 7;
        const size_t R0 = (size_t)b * TPB + rc * 64;
        const bf16* pr = pre + R0 * 4096 + ((nb >> 1) * 4 + (nb & 1) * 2 + dir) * 256 + (ch & 127); const bf16* px = xcb + R0 * 1024 + ch;
        const float rab = P.in[I_RAB][dir * 1024 + ch], ixb = P.in[I_IXB][dir * 1024 + ch], sp = sp8[dir * 1024 + ch];
        float A = 0.f, hh = 0.f;
        for (int i0 = 0; i0 < 64; i0 += 16) {
            bf16 w0[16], w1[16], w2[16];
#pragma unroll
            for (int e = 0; e < 16; ++e) { const int r = dir ? (63 - i0 - e) : (i0 + e); w0[e] = pr[(size_t)r * 4096]; w1[e] = pr[(size_t)r * 4096 + 128]; w2[e] = px[(size_t)r * 1024]; }
#pragma unroll
            for (int e = 0; e < 16; ++e) { float la, bb; lru_ab(bf2f(w0[e]), bf2f(w1[e]), bf2f(w2[e]), rab, ixb, sp, la, bb); A += la; hh = __expf(la) * hh + bb; }
        }
        carr[t] = make_float2(A, hh);
    }
}
__device__ __forceinline__ float gelu_tanh_(float x) { return x * sigmoidf_(1.5957691216057308f * (x + 0.044715f * x * x * x)); }
__device__ __forceinline__ void lru_s2_phase(const Params& P, LAS unsigned char* lds) {
    const bf16* pre = (const bf16*)(P.ws + WS_LAB); const bf16* xcb = (const bf16*)(P.ws + WS_XC); const float2* carr = (const float2*)(P.ws + WS_CARR); const float* sp8 = (const float*)(P.ws + WS_SP8);
    const bf16* prec = (const bf16*)(P.ws + WS_PREC); bf16* mix = (bf16*)(P.ws + WS_MIX);
    LAS float* hf = (LAS float*)lds;
    const int tid = threadIdx.x, GT = gridDim.x * 512;
    for (int t = blockIdx.x * 512 + tid; t < NBATCH * 64 * 1024; t += GT) {
        const int ch = t & 1023, rc = 4 + ((t >> 10) & 63), b = t >> 16, nb = ch >> 7; const size_t R0 = (size_t)b * TPB + rc * 64;
        const bf16* px = xcb + R0 * 1024 + ch;
        for (int dir = 0; dir < 2; ++dir) {
            const bf16* pr = pre + R0 * 4096 + ((nb >> 1) * 4 + (nb & 1) * 2 + dir) * 256 + (ch & 127);
            const float rab = P.in[I_RAB][dir * 1024 + ch], ixb = P.in[I_IXB][dir * 1024 + ch], sp = sp8[dir * 1024 + ch];
            float hh = 0.f;
            const float2* cp = carr + ((size_t)(b * 2 + dir) * 68) * 1024 + ch;
            if (dir == 0) { for (int c = 0; c < rc; ++c) { const float2 ab = cp[(size_t)c * 1024]; hh = __expf(ab.x) * hh + ab.y; } }
            else { for (int c = 3; c >= 0; --c) { const float2 ab = cp[(size_t)c * 1024]; hh = __expf(ab.x) * hh + ab.y; }
                   for (int c = 67; c > rc; --c) { const float2 ab = cp[(size_t)c * 1024]; hh = __expf(ab.x) * hh + ab.y; } }
            for (int i0 = 0; i0 < 64; i0 += 16) {
                bf16 w0[16], w1[16], w2[16], gt[16];
#pragma unroll
                for (int e = 0; e < 16; ++e) { const int r = dir ? (63 - i0 - e) : (i0 + e); w0[e] = pr[(size_t)r * 4096]; w1[e] = pr[(size_t)r * 4096 + 128]; w2[e] = px[(size_t)r * 1024];
                    gt[e] = dir ? prec[(R0 + r) * RIW + 1024 + ch] : (bf16)0; }
#pragma unroll
                for (int e = 0; e < 16; ++e) { const int r = dir ? (63 - i0 - e) : (i0 + e); float la, bb; lru_ab(bf2f(w0[e]), bf2f(w1[e]), bf2f(w2[e]), rab, ixb, sp, la, bb);
                    hh = __expf(la) * hh + bb;
                    if (dir == 0) hf[r * 512 + tid] = hh;
                    else mix[(R0 + r) * 2048 + ch] = f2bf(gelu_tanh_(bf2f(gt[e])) * (hf[r * 512 + tid] + hh)); }
            }
        }
    }
}
constexpr int NPHASE = 23;
__global__ void __launch_bounds__(512, 2) mega_fwd(Params P, int lo, int hi) {
    extern __shared__ __attribute__((aligned(16))) unsigned char lds_raw[];
    cg::grid_group grid = cg::this_grid();
    LAS unsigned char* lds = (LAS unsigned char*)lds_raw;
    unsigned char* ws = P.ws;
    const int G = gridDim.x, bid = blockIdx.x;
    float* mod = (float*)(ws + WS_MOD);
#ifndef PH_ONLY
#define PH_ONLY -1
#endif
#define IN(k) ((PH_ONLY < 0 || PH_ONLY == (k)) && lo <= (k) && (k) < hi)
#define SEAM(k) do { if (IN(k) && IN((k) + 1)) { __builtin_amdgcn_fence(__ATOMIC_RELEASE, "agent"); asm volatile("s_waitcnt vmcnt(0) lgkmcnt(0)" ::: "memory"); grid.sync(); __builtin_amdgcn_fence(__ATOMIC_ACQUIRE, "agent"); } } while (0)
    if (IN(0)) { phase0(P, lds); } SEAM(0);
    if (IN(1)) { norm_phase<0>(P, P.in[I_NMIX], mod + 0 * DM, false); } SEAM(1);
    if (IN(2)) { pg8::Gemm g{(const bf16*)(ws + WS_U), (const bf16*)(ws + WS_WATT), MT, AIWP, 2048, 2048, 0}; pg8::StaticOrder S; S.init(MT, AIWP, G, bid, 0);
        pg8::EpiStore E{(bf16*)(ws + WS_PROJ), AIWP}; pg8::gemm_phase<pg8::EpiStore, pg8::StaticOrder, true, true>(lds, g, S, E); } SEAM(2);
    if (IN(3)) { attn_post_phase(P); } SEAM(3);
    if (IN(4)) {
        { pg8::Gemm g{(const bf16*)(ws + WS_CQN), (const bf16*)(ws + WS_WUQ), MT, 1536, 512, 512, 0}; pg8::StaticOrder S; S.init(MT, 1536, G, bid, 0);
          pg8::EpiStore E{(bf16*)(ws + WS_QB), 1536}; pg8::gemm_phase<pg8::EpiStore, pg8::StaticOrder, true, true>(lds, g, S, E); }
        { pg8::Gemm g{(const bf16*)(ws + WS_CKVN), (const bf16*)(ws + WS_WUKV), MT, 2048, 512, 512, 0}; pg8::StaticOrder S; S.init(MT, 2048, G, bid, 0);
          pg8::EpiStore E{(bf16*)(ws + WS_KVB), 2048}; pg8::gemm_phase<pg8::EpiStore, pg8::StaticOrder, true, true>(lds, g, S, E); }
    } SEAM(4);
    if (IN(5)) { attn_phase(P, (char*)lds_raw); } SEAM(5);
    if (IN(6)) { pg8::Gemm g{(const bf16*)(ws + WS_MIX), (const bf16*)(ws + WS_WMIX0), MT, 2048, 2048, 2048, 0}; pg8::StaticOrder S; S.init(MT, 2048, G, bid, 0);
        pg8::EpiResGate E{(float*)(ws + WS_H), mod + 2 * DM}; pg8::gemm_phase<pg8::EpiResGate, pg8::StaticOrder, true, true>(lds, g, S, E); } SEAM(6);
    if (IN(7)) { norm_phase<1>(P, P.in[I_NFFN], mod + 3 * DM, false); } SEAM(7);
    if (IN(8)) { pg8::Gemm g{(const bf16*)(ws + WS_U), (const bf16*)(ws + WS_WGU0), MT, 2 * FFH, 2048, 2048, 0}; pg8::StaticOrder S; S.init(MT, 2 * FFH, G, bid, 0);
        pg8::EpiSwiGLU E{(bf16*)(ws + WS_HID), FFH}; pg8::gemm_phase<pg8::EpiSwiGLU, pg8::StaticOrder, true, true>(lds, g, S, E); } SEAM(8);
    if (IN(9)) { pg8::Gemm g{(const bf16*)(ws + WS_HID), (const bf16*)(ws + WS_WD0), MT, 2048, FFH, FFH, 0}; pg8::StaticOrder S; S.init(MT, 2048, G, bid, 0);
        pg8::EpiResGate E{(float*)(ws + WS_H), mod + 5 * DM}; pg8::gemm_phase<pg8::EpiResGate, pg8::StaticOrder, true, true>(lds, g, S, E); } SEAM(9);
    float* mod1 = mod + 5 * MODW;
    if (IN(10)) { norm_phase<1>(P, P.in[I_NMIX] + DM, mod1 + 0 * DM, false); } SEAM(10);
    if (IN(11)) { pg8::Gemm g{(const bf16*)(ws + WS_U), (const bf16*)(ws + WS_WREC), MT, RIW, 2048, 2048, 0}; pg8::StaticOrder S; S.init(MT, RIW, G, bid, 0);
        pg8::EpiStore E{(bf16*)(ws + WS_PREC), RIW}; pg8::gemm_phase<pg8::EpiStore, pg8::StaticOrder, true, true>(lds, g, S, E); } SEAM(11);
    if (IN(12)) { conv_phase(P); hg_a_phase(P, lds); } SEAM(12);
    if (IN(13)) { hg_b_phase(P); } SEAM(13);
    if (IN(14)) { hg_c_phase(P, lds); } SEAM(14);
    if (IN(15)) { pg8::Gemm g{(const bf16*)(ws + WS_XC), (const bf16*)(ws + WS_WLRU), MT, 4096, 256, 1024, 1}; pg8::StaticOrder S; S.init(MT, 4096, G, bid, 0);
        pg8::EpiStore E{(bf16*)(ws + WS_LAB), 4096}; pg8::gemm_phase<pg8::EpiStore, pg8::StaticOrder, true, true>(lds, g, S, E); } SEAM(15);
    if (IN(16)) { lru_s1_phase(P); } SEAM(16);
    if (IN(17)) { lru_s2_phase(P, lds); } SEAM(17);
    if (IN(18)) { pg8::Gemm g{(const bf16*)(ws + WS_MIX), (const bf16*)(ws + WS_WMIX1), MT, 2048, 2048, 2048, 0}; pg8::StaticOrder S; S.init(MT, 2048, G, bid, 1);
        pg8::EpiResGate E{(float*)(ws + WS_H), mod1 + 2 * DM}; pg8::gemm_phase<pg8::EpiResGate, pg8::StaticOrder, true, true>(lds, g, S, E); } SEAM(18);
    if (IN(19)) { norm_phase<1>(P, P.in[I_NFFN] + DM, mod1 + 3 * DM, true); } SEAM(19);
    if (IN(20)) { pg8::Gemm g{(const bf16*)(ws + WS_U), (const bf16*)(ws + WS_WGU1), MT, 2 * FFH, 2048, 2048, 0}; pg8::StaticOrder S; S.init(MT, 2 * FFH, G, bid, 1);
        pg8::EpiSwiGLU E{(bf16*)(ws + WS_HID), FFH}; pg8::gemm_phase<pg8::EpiSwiGLU, pg8::StaticOrder, true, true>(lds, g, S, E); } SEAM(20);
    if (IN(21)) { pg8::Gemm g{(const bf16*)(ws + WS_HID), (const bf16*)(ws + WS_WD1), MT, 2048, FFH, FFH, 0}; pg8::StaticOrder S; S.init(MT, 2048, G, bid, 1);
        pg8::EpiResGate E{(float*)(ws + WS_H), mod1 + 5 * DM}; pg8::gemm_phase<pg8::EpiResGate, pg8::StaticOrder, true, true>(lds, g, S, E); } SEAM(21);
    if (IN(22)) { norm_phase<2>(P, P.in[I_FNW], nullptr, true); }
#undef IN
#undef SEAM
}

extern "C" void kernel_launch(void* const* d_in, const int* in_sizes, int n_in, void* d_out, int out_size, void* d_ws, size_t ws_size, hipStream_t stream) {
    static int grid = 0;
    if (grid == 0) {
        if (n_in != 30 || ws_size < WS_END) { fprintf(stderr, "kernel_launch: n_in %d ws %zu (need 30, >= %zu)\n", n_in, ws_size, (size_t)WS_END); }
        int dev = 0, cus = 0, per_cu = 0;
        hipGetDevice(&dev); hipDeviceGetAttribute(&cus, hipDeviceAttributeMultiprocessorCount, dev);
        if (hipFuncSetAttribute((const void*)mega_fwd, hipFuncAttributeMaxDynamicSharedMemorySize, LDS_BYTES) != hipSuccess) fprintf(stderr, "kernel_launch: hipFuncSetAttribute failed\n");
        if (hipOccupancyMaxActiveBlocksPerMultiprocessor(&per_cu, (const void*)mega_fwd, 512, LDS_BYTES) != hipSuccess || per_cu < 1) { fprintf(stderr, "kernel_launch: occupancy query says %d\n", per_cu); per_cu = 1; }
        (void)hipGetLastError();
        grid = cus * 1;
        if (grid <= 0) grid = 256;
    }
    Params p{};
    for (int i = 0; i < 30; ++i) p.in[i] = (const float*)d_in[i];
    p.out = (float*)d_out; p.ws = (unsigned char*)d_ws;
    int lo = 0, hi = NPHASE;
    void* args[] = {(void*)&p, (void*)&lo, (void*)&hi};
    hipError_t e = hipLaunchCooperativeKernel((const void*)mega_fwd, dim3(grid), dim3(512), args, LDS_BYTES, stream);
    if (e != hipSuccess) fprintf(stderr, "kernel_launch: cooperative launch failed: %s (grid %d)\n", hipGetErrorString(e), grid);
}
```

```cpp
#include <hip/hip_runtime.h>
#include <hip/hip_bf16.h>
#include <hip/hip_cooperative_groups.h>
#include <cstdio>
#include <cstdint>
namespace cg = cooperative_groups;
#ifndef TPH_LO
#define TPH_LO -1
#define TPH_HI -1
#endif

constexpr int DM = 2048, NBATCH = 4, SEQL = 4096, CTXL = 256, TPB = SEQL + CTXL, MT = NBATCH * TPB;
constexpr int FFH = 5632, AIW = 2624, AIWP = 2816, RIW = 7168, MODW = 6 * DM;
constexpr float EPS = 1e-6f;
constexpr size_t MiB = 1u << 20;
constexpr size_t WS_MOD = 0;
constexpr size_t WS_COSA = 1 * MiB, WS_SINA = 2 * MiB;
constexpr size_t WS_COSB = 3 * MiB, WS_SINB = 3 * MiB + 512 * 1024;
constexpr size_t WS_LB = 4 * MiB, WS_SP8 = 4 * MiB + 8192;
constexpr size_t WS_CARR = 5 * MiB;
constexpr size_t WS_HGD = 10 * MiB;
constexpr size_t WS_PART = 672 * MiB;
constexpr size_t WS_XBAR = 14 * MiB;
constexpr size_t WS_H = 16 * MiB;
constexpr size_t WS_U = 152 * MiB;
constexpr size_t WS_MIX = 220 * MiB;
constexpr size_t WS_WREC = 288 * MiB, WS_WLRU = 316 * MiB, WS_WMIX1 = 318 * MiB, WS_WGU1 = 326 * MiB, WS_WD1 = 370 * MiB;
constexpr size_t WS_WATT = 392 * MiB, WS_WUQ = 403 * MiB, WS_WUKV = 403 * MiB + 1536 * 512 * 2  , WS_WMIX0 = 407 * MiB, WS_WGU0 = 415 * MiB, WS_WD0 = 459 * MiB;
constexpr size_t WS_F = 482 * MiB;
constexpr size_t WS_PROJ = WS_F;
constexpr size_t WS_QA = 576 * MiB, WS_KA = 610 * MiB, WS_CQN = 619 * MiB, WS_CKVN = 636 * MiB, WS_KR = 653 * MiB, WS_QB = 656 * MiB;
constexpr size_t WS_KVB = WS_U;
constexpr size_t WS_HID = WS_F;
constexpr size_t WS_LAB = 392 * MiB;
constexpr size_t WS_SS = WS_LAB;
constexpr size_t WS_PREC = 528 * MiB;
constexpr size_t WS_HG = 596 * MiB;
constexpr int PRW = 2048;
constexpr size_t WS_XC = WS_U;
constexpr size_t WS_END = 768 * MiB;
constexpr int LDS_BYTES = 147456;

#define LAS __attribute__((address_space(3)))
typedef unsigned short bf16;
typedef unsigned v4u __attribute__((ext_vector_type(4)));
typedef unsigned v2u __attribute__((ext_vector_type(2)));
typedef float f32x4 __attribute__((ext_vector_type(4)));
typedef short bf16x8 __attribute__((ext_vector_type(8)));
typedef __bf16 bf2_t __attribute__((ext_vector_type(2)));
typedef float f2_t __attribute__((ext_vector_type(2)));
__device__ __forceinline__ unsigned cvtpk(float lo, float hi) { f2_t v = {lo, hi}; bf2_t r = __builtin_convertvector(v, bf2_t); return __builtin_bit_cast(unsigned, r); }
__device__ __forceinline__ float bflo(unsigned w) { return __uint_as_float(w << 16); }
__device__ __forceinline__ float bfhi(unsigned w) { return __uint_as_float(w & 0xffff0000u); }
__device__ __forceinline__ float bf2f(bf16 h) { return __uint_as_float((unsigned)h << 16); }
__device__ __forceinline__ bf16 f2bf(float f) { return (bf16)(cvtpk(f, f) & 0xffffu); }
__device__ __forceinline__ float wave_sum(float v) {
#pragma unroll
    for (int o = 1; o < 64; o <<= 1) v += __shfl_xor(v, o);
    return v;
}
__device__ __forceinline__ float sigmoidf_(float x) { return __builtin_amdgcn_rcpf(1.f + __expf(-x)); }
__device__ __forceinline__ float siluf_(float x) { return x * sigmoidf_(x); }
#define LDS_WAIT() asm volatile("s_waitcnt lgkmcnt(0)" ::: "memory")
namespace pg8 {
#define PG8_LAS __attribute__((address_space(3)))
typedef unsigned short bf16_t;
typedef short bf16x8 __attribute__((ext_vector_type(8)));
typedef float f32x4 __attribute__((ext_vector_type(4)));
typedef unsigned u32x4 __attribute__((ext_vector_type(4)));
constexpr int BM = 256, BK = 64, HALF = 128, HTB = HALF * BK * 2  , STAGE_BYTES = 8 * HTB, NXCD = 8, WGM = 8;

__host__ __device__ __forceinline__ int lds_byte(int r, int c) { const int st = (r >> 4) * 2 + (c >> 5), rr = r & 15, cc = c & 31, ob = rr * 64 + cc * 2; return st * 1024 + (ob ^ (((ob >> 9) & 1) << 5)); }
__host__ __device__ __forceinline__ void stage_rc(int b, int& R, int& C) { const int st = b / 1024, sb = b % 1024, swz = sb ^ (((sb >> 9) & 1) << 5); R = (st >> 1) * 16 + swz / 64; C = (st & 1) * 32 + (swz % 64) / 2; }
__host__ __device__ __forceinline__ int perm32(int rho) { const int n = rho >> 4, i = rho & 15; return 8 * (i >> 2) + 4 * n + (i & 3); }
struct Unit { int pm, pn, k0, nt; };
struct Gemm { const bf16_t* A; const bf16_t* Bt; int M, N, K, lda, grp;
    __device__ __forceinline__ const char* abase(const Unit& u) const { return (const char*)A + (size_t)u.pm * 256 * lda * 2 + (grp == 1 ? (size_t)(u.pn >> 1) * 256 : (grp == 2 && u.pn >= 6) ? (size_t)17408 * 512 * 2 : 0) + (size_t)u.k0 * 128; }
    __device__ __forceinline__ const char* bbase(const Unit& u) const { return (const char*)Bt + (size_t)u.pn * 256 * K * 2 + (size_t)u.k0 * 128; } };
struct StaticOrder {
    int nM, nN, nwg, G, c, skip, ntf, split;
    __device__ void init(int M, int N, int G_, int c_, int skip_, int K_ = 0, int split_ = 0) { ntf = K_ / BK; split = split_; if (split_) skip_ = 1; skip = skip_; nM = skip_ ? 64 : M / BM; nN = N / BM; nwg = nM * nN; G = G_; c = c_; }
    __device__ bool next(int i, Unit& u) const {
        u.k0 = 0; u.nt = ntf;
        if (split && i >= 2) { if (i > 2 || c >= 128) return false; const int uc = c >> 2; u.pm = (uc >> 3) * 17; u.pn = uc & 7; u.nt = ntf >> 2; u.k0 = (c & 3) * u.nt; return true; }
        const long L = (long)i * G + c; if (L >= nwg) return false;
        int wgid = (int)L; { const int q = nwg / NXCD, r = nwg % NXCD, xcd = wgid % NXCD, off = wgid / NXCD; wgid = (xcd < r ? xcd * (q + 1) : r * (q + 1) + (xcd - r) * q) + off; }
        const int nig = WGM * nN, gid = wgid / nig, fm = gid * WGM, gsz = (nM - fm) < WGM ? (nM - fm) : WGM;
        int pm = fm + ((wgid % nig) % gsz); u.pn = (wgid % nig) / gsz;
        if (skip) pm = (pm >> 4) * 17 + 1 + (pm & 15);
        u.pm = pm; return true;
    }
    __device__ __forceinline__ void a_ready(const Unit&) const {}
    __device__ __forceinline__ void done(const Unit&) const {}
};
__device__ __forceinline__ unsigned cvt_pk_bf16(float lo, float hi) { return ::cvtpk(lo, hi); }
__device__ __forceinline__ float sigm(float x) { return __builtin_amdgcn_rcpf(1.f + __expf(-x)); }
struct EpiStore {
    static constexpr bool PERM = true, AFTER_DRAIN = false;
    bf16_t* O; int ldc;
    __device__ __forceinline__ void operator()(const f32x4 (&acc)[2][2][4][2], const Unit& u, int wr, int wc, int fr, int fq) const {
        const int row0 = u.pm * BM + wr * 64 + fr, col0 = u.pn * BM + wc * 32 + 8 * fq;
#pragma unroll
        for (int ai = 0; ai < 2; ++ai)
#pragma unroll
            for (int m = 0; m < 4; ++m) { bf16_t* rowp = O + (size_t)(row0 + ai * HALF + m * 16) * ldc + col0;
#pragma unroll
                for (int bj = 0; bj < 2; ++bj) { const f32x4 v0 = acc[ai][bj][m][0], v1 = acc[ai][bj][m][1];
                    u32x4 w; w.x = cvt_pk_bf16(v0[0], v0[1]); w.y = cvt_pk_bf16(v0[2], v0[3]); w.z = cvt_pk_bf16(v1[0], v1[1]); w.w = cvt_pk_bf16(v1[2], v1[3]);
                    *(u32x4*)(rowp + bj * HALF) = w; } }
    }
};
struct EpiMla {
    static constexpr bool PERM = true, AFTER_DRAIN = false;
    bf16_t* QB; bf16_t* KVB;
    __device__ __forceinline__ void operator()(const f32x4 (&acc)[2][2][4][2], const Unit& u, int wr, int wc, int fr, int fq) const {
        const bool kv = u.pn >= 6; const int ldc = kv ? 2048 : 1536;
        bf16_t* O = kv ? KVB : QB;
        const int row0 = u.pm * BM + wr * 64 + fr, col0 = (kv ? u.pn - 6 : u.pn) * BM + wc * 32 + 8 * fq;
#pragma unroll
        for (int ai = 0; ai < 2; ++ai)
#pragma unroll
            for (int m = 0; m < 4; ++m) { bf16_t* rowp = O + (size_t)(row0 + ai * HALF + m * 16) * ldc + col0;
#pragma unroll
                for (int bj = 0; bj < 2; ++bj) { const f32x4 v0 = acc[ai][bj][m][0], v1 = acc[ai][bj][m][1];
                    u32x4 w; w.x = cvt_pk_bf16(v0[0], v0[1]); w.y = cvt_pk_bf16(v0[2], v0[3]); w.z = cvt_pk_bf16(v1[0], v1[1]); w.w = cvt_pk_bf16(v1[2], v1[3]);
                    *(u32x4*)(rowp + bj * HALF) = w; } }
    }
};
struct EpiRec {
    static constexpr bool PERM = true, AFTER_DRAIN = false;
    bf16_t* P2; bf16_t* HG;
    __device__ __forceinline__ void operator()(const f32x4 (&acc)[2][2][4][2], const Unit& u, int wr, int wc, int fr, int fq) const {
        const int row0 = u.pm * BM + wr * 64 + fr, b = u.pm / 17, t0 = (u.pm % 17) * BM + wr * 64 + fr;
#pragma unroll
        for (int bj = 0; bj < 2; ++bj) {
            bf16_t* base; size_t rstride;
            if (u.pn < 8) { base = P2 + (size_t)row0 * 2048 + u.pn * BM + bj * HALF + wc * 32 + 8 * fq; rstride = 2048; }
            else { const int sec = (u.pn - 8) >> 2, head = ((u.pn - 8) & 3) * 2 + bj;
                base = HG + ((((size_t)sec * 4 + b) * 8 + head) * 4352 + t0) * 128 + wc * 32 + 8 * fq; rstride = 128; }
#pragma unroll
            for (int ai = 0; ai < 2; ++ai)
#pragma unroll
                for (int m = 0; m < 4; ++m) { const f32x4 v0 = acc[ai][bj][m][0], v1 = acc[ai][bj][m][1];
                    u32x4 w; w.x = cvt_pk_bf16(v0[0], v0[1]); w.y = cvt_pk_bf16(v0[2], v0[3]); w.z = cvt_pk_bf16(v1[0], v1[1]); w.w = cvt_pk_bf16(v1[2], v1[3]);
                    *(u32x4*)(base + (size_t)(ai * HALF + m * 16) * rstride) = w; }
        }
    }
};
struct EpiSwiGLU {
    static constexpr bool PERM = true, AFTER_DRAIN = false;
    bf16_t* O; int ldc;
    __device__ __forceinline__ void operator()(const f32x4 (&acc)[2][2][4][2], const Unit& u, int wr, int wc, int fr, int fq) const {
        const int row0 = u.pm * BM + wr * 64 + fr, col0 = u.pn * HALF + wc * 32 + 8 * fq;
#pragma unroll
        for (int ai = 0; ai < 2; ++ai)
#pragma unroll
            for (int m = 0; m < 4; ++m) { bf16_t* rowp = O + (size_t)(row0 + ai * HALF + m * 16) * ldc + col0;
                float r[8];
#pragma unroll
                for (int n = 0; n < 2; ++n)
#pragma unroll
                    for (int e = 0; e < 4; ++e) { const float g = acc[ai][0][m][n][e], up = acc[ai][1][m][n][e]; r[n * 4 + e] = g * sigm(g) * up; }
                u32x4 w; w.x = cvt_pk_bf16(r[0], r[1]); w.y = cvt_pk_bf16(r[2], r[3]); w.z = cvt_pk_bf16(r[4], r[5]); w.w = cvt_pk_bf16(r[6], r[7]);
                *(u32x4*)rowp = w; }
    }
};
struct EpiResGate {
    static constexpr bool PERM = false, AFTER_DRAIN = false;
    float* H; const float* gate; float* part; int ntf; const float* xin; const float* cin;
    __device__ __forceinline__ void operator()(const f32x4 (&acc)[2][2][4][2], const Unit& u, int wr, int wc, int fr, int fq) const {
        const int cond = (u.pm % 17 == 0) ? 4 : u.pm / 17;
        const float* gv = gate + (size_t)cond * 12288;
        const int col0 = u.pn * BM + wc * 32 + 4 * fq;
        const bool sl = u.nt != ntf;
        const int row0 = sl ? (u.k0 / u.nt) * 1024 + (u.pm / 17) * BM + wr * 64 + fr : u.pm * BM + wr * 64 + fr;
        float* base = sl ? part : H;
        f32x4 g4[2][2];
#pragma unroll
        for (int bj = 0; bj < 2; ++bj)
#pragma unroll
            for (int n = 0; n < 2; ++n) g4[bj][n] = *(const f32x4*)(gv + col0 + bj * HALF + n * 16);
#pragma unroll
        for (int ai = 0; ai < 2; ++ai)
#pragma unroll
            for (int m = 0; m < 4; ++m) { float* rowp = base + (size_t)(row0 + ai * HALF + m * 16) * 2048 + col0;
                const int rl = wr * 64 + fr + ai * HALF + m * 16, tb_ = u.pm % 17, b_ = u.pm / 17;
                const float* rdp = (xin == nullptr) ? rowp : (tb_ == 0 ? cin + ((size_t)b_ * 256 + rl) * 2048 + col0 : xin + ((size_t)b_ * 4096 + (tb_ - 1) * 256 + rl) * 2048 + col0);
#pragma unroll
                for (int bj = 0; bj < 2; ++bj)
#pragma unroll
                    for (int n = 0; n < 2; ++n) { f32x4* p = (f32x4*)(rowp + bj * HALF + n * 16); const f32x4 ga = g4[bj][n] * acc[ai][bj][m][n]; if (sl) *p = ga; else *p = *(const f32x4*)(rdp + bj * HALF + n * 16) + ga; }
                asm volatile("" ::: "memory"); }
    }
};
template <class Epi, class Sched, bool ALIGN_EPI = false, bool SP2 = false>
__device__ __forceinline__ void gemm_phase(PG8_LAS unsigned char* lds, const Gemm g, const Sched& S, const Epi& E) {
    const int tid = threadIdx.x, wid = __builtin_amdgcn_readfirstlane(tid >> 6), lane = tid & 63, wr = wid >> 2, wc = wid & 3, fr = lane & 15, fq = lane >> 4;
    const int K = g.K; int nt = K / BK;
    unsigned voffA[2], voffB[2];
#pragma unroll
    for (int i = 0; i < 2; ++i) { int R, C; stage_rc(tid * 16 + i * 8192, R, C); const int Rb = Epi::PERM ? ((R & ~31) + perm32(R & 31)) : R;
        voffA[i] = (unsigned)(R * g.lda + C) * 2u; voffB[i] = (unsigned)(Rb * K + C) * 2u; }
    const size_t kstep = (size_t)(BK * 2);
    const size_t hstep = (size_t)HALF * K * 2; const size_t hstepA = (size_t)HALF * g.lda * 2;
    const size_t tstep = 2 * hstep;
    const unsigned ldsw = (unsigned)wid * 1024u;
    const int aoff = lds_byte(wr * 64 + fr, fq * 8), boff = lds_byte(wc * 32 + fr, fq * 8);
#define PG8_SA(b, h) (((b) * 2 + (h)) * HTB)
#define PG8_SB(b, h) ((4 + (b) * 2 + (h)) * HTB)
#define PG8_STAGE(bufoff, gbase, voff) do { _Pragma("unroll") for (int _i = 0; _i < 2; ++_i) \
        __builtin_amdgcn_global_load_lds((const unsigned*)((const char*)(gbase) + (voff)[_i]), (PG8_LAS unsigned*)(lds + (bufoff) + ldsw + _i * 8192), 16, 0, 0); } while (0)
#define PG8_LDA(dst, b, h) do { _Pragma("unroll") for (int m = 0; m < 4; ++m) _Pragma("unroll") for (int k = 0; k < 2; ++k) dst[m][k] = *(const PG8_LAS bf16x8*)(lds + PG8_SA(b, h) + aoff + m * 2048 + k * 1024); } while (0)
#define PG8_LDB(dst, b, h) do { _Pragma("unroll") for (int n = 0; n < 2; ++n) _Pragma("unroll") for (int k = 0; k < 2; ++k) dst[n][k] = *(const PG8_LAS bf16x8*)(lds + PG8_SB(b, h) + boff + n * 2048 + k * 1024); } while (0)
#define PG8_MMA(ai, bj, At, Bt) do { __builtin_amdgcn_s_setprio(1); _Pragma("unroll") for (int m = 0; m < 4; ++m) _Pragma("unroll") for (int n = 0; n < 2; ++n) _Pragma("unroll") for (int k = 0; k < 2; ++k) \
        acc[ai][bj][m][n] = __builtin_amdgcn_mfma_f32_16x16x32_bf16(Bt[n][k], At[m][k], acc[ai][bj][m][n], 0, 0, 0); __builtin_amdgcn_s_setprio(0); } while (0)
#define PG8_WAIT_V(n) asm volatile("s_waitcnt vmcnt(" #n ")" ::: "memory")
#define PG8_WAIT_L(n) asm volatile("s_waitcnt lgkmcnt(" #n ")" ::: "memory")
#define PG8_BAR __builtin_amdgcn_s_barrier()
#define PG8_SCHED __builtin_amdgcn_sched_barrier(0)
    Unit cur, nxt; int ui = 0;
    if (!S.next(0, cur)) return;
    nt = cur.nt;
    f32x4 acc[2][2][4][2];
#pragma unroll
    for (int a = 0; a < 2; ++a)
#pragma unroll
        for (int b = 0; b < 2; ++b)
#pragma unroll
            for (int m = 0; m < 4; ++m)
#pragma unroll
                for (int n = 0; n < 2; ++n) acc[a][b][m][n] = (f32x4){0.f, 0.f, 0.f, 0.f};
    bf16x8 At[4][2], B0[2][2], B1[2][2];
    const char* cA = g.abase(cur); const char* cB = g.bbase(cur);
    S.a_ready(cur);
    if constexpr (SP2) {
        PG8_STAGE(PG8_SB(0, 0), cB, voffB); PG8_STAGE(PG8_SB(0, 1), cB + hstep, voffB); PG8_STAGE(PG8_SA(0, 0), cA, voffA); PG8_STAGE(PG8_SA(0, 1), cA + hstepA, voffA);
        if (wr == 1) PG8_BAR;
        PG8_WAIT_V(2); PG8_BAR;
        PG8_STAGE(PG8_SB(1, 0), cB + kstep, voffB); PG8_STAGE(PG8_SA(1, 0), cA + kstep, voffA); PG8_STAGE(PG8_SB(1, 1), cB + hstep + kstep, voffB);
        PG8_WAIT_V(6); PG8_BAR;
    } else {
        PG8_STAGE(PG8_SB(0, 0), cB, voffB); PG8_STAGE(PG8_SA(0, 0), cA, voffA); PG8_STAGE(PG8_SB(0, 1), cB + hstep, voffB); PG8_STAGE(PG8_SA(0, 1), cA + hstepA, voffA);
        if (wr == 1) PG8_BAR;
        PG8_WAIT_V(4); PG8_BAR;
        PG8_STAGE(PG8_SB(1, 0), cB + kstep, voffB); PG8_STAGE(PG8_SA(1, 0), cA + kstep, voffA); PG8_STAGE(PG8_SB(1, 1), cB + hstep + kstep, voffB);
        PG8_WAIT_V(6); PG8_BAR;
    }
    for (;;) {
        const bool has_next = S.next(ui + 1, nxt);
        const char* nA = has_next ? g.abase(nxt) : cA; const char* nB = has_next ? g.bbase(nxt) : cB;
        for (int t = 0; t < nt; t += 2) {
            const bool last = (t == nt - 2);
            const char* a1 = cA + (size_t)(t + 1) * kstep;
            const char* a2 = last ? nA : cA + (size_t)(t + 2) * kstep; const char* b2 = last ? nB : cB + (size_t)(t + 2) * kstep;
            const char* a3 = a2 + kstep; const char* b3 = b2 + kstep;
            if (last && has_next) S.a_ready(nxt);
            if constexpr (SP2) {
            PG8_LDB(B0, 0, 0); PG8_LDB(B1, 0, 1); PG8_SCHED; PG8_LDA(At, 0, 0); PG8_STAGE(PG8_SA(1, 1), a1 + hstepA, voffA);
            PG8_WAIT_V(8); PG8_WAIT_L(0); PG8_BAR; PG8_MMA(0, 0, At, B0); PG8_MMA(0, 1, At, B1); PG8_BAR; PG8_SCHED;
            PG8_LDA(At, 0, 1); PG8_STAGE(PG8_SB(0, 0), b2, voffB); PG8_STAGE(PG8_SB(0, 1), b2 + hstep, voffB); PG8_STAGE(PG8_SA(0, 0), a2, voffA);
            PG8_WAIT_V(8); PG8_WAIT_L(0); PG8_BAR; PG8_MMA(1, 0, At, B0); PG8_MMA(1, 1, At, B1); PG8_BAR; PG8_SCHED;
            PG8_LDB(B0, 1, 0); PG8_LDB(B1, 1, 1); PG8_SCHED; PG8_LDA(At, 1, 0); PG8_STAGE(PG8_SA(0, 1), a2 + hstepA, voffA);
            PG8_WAIT_V(8); PG8_WAIT_L(0); PG8_BAR; PG8_MMA(0, 0, At, B0); PG8_MMA(0, 1, At, B1); PG8_BAR; PG8_SCHED;
            PG8_LDA(At, 1, 1); PG8_STAGE(PG8_SB(1, 0), b3, voffB); PG8_STAGE(PG8_SB(1, 1), b3 + hstep, voffB); PG8_STAGE(PG8_SA(1, 0), a3, voffA);
            PG8_WAIT_V(8); PG8_WAIT_L(0); PG8_BAR; PG8_MMA(1, 0, At, B0); PG8_MMA(1, 1, At, B1); PG8_BAR; PG8_SCHED;
            } else {
            PG8_LDB(B0, 0, 0); PG8_SCHED; PG8_LDA(At, 0, 0); PG8_STAGE(PG8_SA(1, 1), a1 + hstepA, voffA);
            PG8_WAIT_L(8); PG8_BAR; PG8_WAIT_L(0); PG8_MMA(0, 0, At, B0); PG8_BAR; PG8_SCHED;
            PG8_LDB(B1, 0, 1); PG8_STAGE(PG8_SB(0, 0), b2, voffB);
            PG8_BAR; PG8_WAIT_L(0); PG8_MMA(0, 1, At, B1); PG8_BAR;
            PG8_LDA(At, 0, 1); PG8_STAGE(PG8_SA(0, 0), a2, voffA);
            PG8_BAR; PG8_WAIT_L(0); PG8_MMA(1, 0, At, B0); PG8_BAR; PG8_SCHED;
            PG8_STAGE(PG8_SB(0, 1), b2 + hstep, voffB);
            PG8_WAIT_V(6); PG8_BAR; PG8_MMA(1, 1, At, B1); PG8_BAR;
            PG8_LDB(B0, 1, 0); PG8_SCHED; PG8_LDA(At, 1, 0); PG8_STAGE(PG8_SA(0, 1), a2 + hstepA, voffA);
            PG8_WAIT_L(8); PG8_BAR; PG8_WAIT_L(0); PG8_MMA(0, 0, At, B0); PG8_BAR; PG8_SCHED;
            PG8_LDB(B1, 1, 1); PG8_STAGE(PG8_SB(1, 0), b3, voffB);
            PG8_BAR; PG8_WAIT_L(0); PG8_MMA(0, 1, At, B1); PG8_BAR;
            PG8_LDA(At, 1, 1); PG8_STAGE(PG8_SA(1, 0), a3, voffA);
            PG8_BAR; PG8_WAIT_L(0); PG8_MMA(1, 0, At, B0); PG8_BAR; PG8_SCHED;
            PG8_STAGE(PG8_SB(1, 1), b3 + hstep, voffB);
            PG8_WAIT_V(6); PG8_BAR; PG8_MMA(1, 1, At, B1); PG8_BAR;
            }
        }
        if constexpr (ALIGN_EPI) { if (wr == 0) PG8_BAR; }
        if constexpr (!Epi::AFTER_DRAIN) { E(acc, cur, wr, wc, fr, fq); S.done(cur); }
        if (!has_next) break;
#pragma unroll
        for (int a = 0; a < 2; ++a)
#pragma unroll
            for (int b = 0; b < 2; ++b)
#pragma unroll
                for (int m = 0; m < 4; ++m)
#pragma unroll
                    for (int n = 0; n < 2; ++n) acc[a][b][m][n] = (f32x4){0.f, 0.f, 0.f, 0.f};
        cur = nxt; cA = nA; cB = nB; ++ui; nt = cur.nt;
        if constexpr (ALIGN_EPI) { if (wr == 1) PG8_BAR; }
    }
    PG8_WAIT_V(0);
    if constexpr (!ALIGN_EPI) { if (wr == 0) PG8_BAR; }
    PG8_BAR;
    if constexpr (Epi::AFTER_DRAIN) { E.fused(acc, cur, wr, wc, fr, fq, lds, wid, lane); S.done(cur); }
#undef PG8_SA
#undef PG8_SB
#undef PG8_STAGE
#undef PG8_LDA
#undef PG8_LDB
#undef PG8_MMA
#undef PG8_WAIT_V
#undef PG8_WAIT_L
#undef PG8_BAR
#undef PG8_SCHED
}
}
namespace attn {
using bf16x8 = __attribute__((ext_vector_type(8))) short;
using s16x4  = __attribute__((ext_vector_type(4))) short;
using f32x16 = __attribute__((ext_vector_type(16))) float;
using u32x4  = __attribute__((ext_vector_type(4))) unsigned;
constexpr int NW = 8, QBLK = 32, KVBLK = 64;
constexpr float THR = 8.f;
constexpr size_t SHM_V = KVBLK * 128 * 2;
#define SBAR() __builtin_amdgcn_sched_barrier(0)
__device__ __forceinline__ int crow(int r, int hi) { return (r & 3) + 8 * (r >> 2) + 4 * hi; }
__device__ __forceinline__ void partialSM(f32x16& p0, f32x16& p1, float& m_reg, float& mn, float& alpha, const float C, const float THRS) {
  float pmax = p0[0];
#pragma unroll
  for (int r = 1; r < 16; ++r) pmax = fmaxf(pmax, p0[r]);
#pragma unroll
  for (int r = 0; r < 16; ++r) pmax = fmaxf(pmax, p1[r]);
  { auto rr = __builtin_amdgcn_permlane32_swap(__float_as_uint(pmax), __float_as_uint(pmax), false, false);
    pmax = fmaxf(__uint_as_float(rr[0]), __uint_as_float(rr[1])); }
  if (__builtin_expect(__all(pmax - m_reg <= THRS), 1)) { mn = m_reg; alpha = 1.f; }
  else { mn = fmaxf(m_reg, pmax); alpha = __builtin_amdgcn_exp2f((m_reg - mn) * C); m_reg = mn; }
  float mnC = -mn * C;
#pragma unroll
  for (int r = 0; r < 16; ++r) p0[r] = fmaf(p0[r], C, mnC);
#pragma unroll
  for (int r = 0; r < 16; ++r) p1[r] = fmaf(p1[r], C, mnC);
#pragma unroll
  for (int r = 0; r < 16; ++r) p0[r] = __builtin_amdgcn_exp2f(p0[r]);
}
__device__ __forceinline__ void finishSM(f32x16& p0, f32x16& p1, float alpha, float& l_reg, bf16x8& pa0, bf16x8& pa1, bf16x8& pa2, bf16x8& pa3) {
#pragma unroll
  for (int r = 0; r < 16; ++r) p1[r] = __builtin_amdgcn_exp2f(p1[r]);
  float ps = 0;
#pragma unroll
  for (int r = 0; r < 16; ++r) ps += p0[r];
#pragma unroll
  for (int r = 0; r < 16; ++r) ps += p1[r];
  { auto rr = __builtin_amdgcn_permlane32_swap(__float_as_uint(ps), __float_as_uint(ps), false, false);
    ps = __uint_as_float(rr[0]) + __uint_as_float(rr[1]); }
  l_reg = l_reg * alpha + ps;
#define PK4(P, BASE, OUT) do { unsigned a0 = cvtpk(P[BASE + 0], P[BASE + 1]), a1 = cvtpk(P[BASE + 2], P[BASE + 3]);   \
    unsigned b0 = cvtpk(P[BASE + 4], P[BASE + 5]), b1 = cvtpk(P[BASE + 6], P[BASE + 7]);                              \
    auto r0 = __builtin_amdgcn_permlane32_swap(a0, b0, false, false); auto r1 = __builtin_amdgcn_permlane32_swap(a1, b1, false, false); \
    u32x4 w = {r0[0], r1[0], r0[1], r1[1]}; OUT = *reinterpret_cast<bf16x8*>(&w); } while (0)
  PK4(p0, 0, pa0); PK4(p0, 8, pa1); PK4(p1, 0, pa2); PK4(p1, 8, pa3);
#undef PK4
}
template <int DQK> __device__ __forceinline__ int kswz(int row, int colB) { return row * (DQK * 2) + (colB ^ ((row & 7) << 4)); }
template <int DQK>
__device__ __forceinline__ void qkt(f32x16& p0, f32x16& p1, const char* Ks, const bf16x8* qr, int r32, int hi) {
  p0 = f32x16{}; p1 = f32x16{};
#pragma unroll
  for (int d0 = 0; d0 < DQK / 16; ++d0) { int cb = (d0 * 16 + hi * 8) * 2;
    bf16x8 b0 = *reinterpret_cast<const bf16x8*>(Ks + kswz<DQK>(r32, cb));
    bf16x8 b1 = *reinterpret_cast<const bf16x8*>(Ks + kswz<DQK>(32 + r32, cb));
    p0 = __builtin_amdgcn_mfma_f32_32x32x16_bf16(b0, qr[d0], p0, 0, 0, 0);
    p1 = __builtin_amdgcn_mfma_f32_32x32x16_bf16(b1, qr[d0], p1, 0, 0, 0); }
}
__device__ __forceinline__ int v_st(int k, int c) { const int kk = (k & ~0xC) | ((k & 4) << 1) | ((k & 8) >> 1); return ((kk >> 3) * 4 + (c >> 5)) * 512 + ((kk & 7) * 32 + (c & 31)) * 2; }
__device__ __forceinline__ int v_rd_base(int lane) { return ((lane & 3) << 3) | (((lane >> 2) & 3) << 6) | (((lane >> 4) & 1) << 5) | (((lane >> 5) & 1) << 8); }
constexpr int v_rd_off(int d0, int ks, int half) { return d0 * 512 + ks * 4096 + half * 2048; }
template <int OFF> __device__ __forceinline__ s16x4 tr_read(int vb) {
  s16x4 r; asm volatile("ds_read_b64_tr_b16 %0, %1 offset:%2" : "=&v"(r) : "v"(vb), "i"(OFF) : "memory"); return r;
}
template <int D0> __device__ __forceinline__ void pv_one(f32x16& od, int vb, bf16x8 pa0, bf16x8 pa1, bf16x8 pa2, bf16x8 pa3) {
  const s16x4 l0 = tr_read<v_rd_off(D0, 0, 0)>(vb), h0 = tr_read<v_rd_off(D0, 0, 1)>(vb), l1 = tr_read<v_rd_off(D0, 1, 0)>(vb), h1 = tr_read<v_rd_off(D0, 1, 1)>(vb);
  const s16x4 l2 = tr_read<v_rd_off(D0, 2, 0)>(vb), h2 = tr_read<v_rd_off(D0, 2, 1)>(vb), l3 = tr_read<v_rd_off(D0, 3, 0)>(vb), h3 = tr_read<v_rd_off(D0, 3, 1)>(vb);
  asm volatile("s_waitcnt lgkmcnt(0)" ::: "memory"); SBAR();
#define PK(L, H) (bf16x8){L[0], L[1], L[2], L[3], H[0], H[1], H[2], H[3]}
  od = __builtin_amdgcn_mfma_f32_32x32x16_bf16(pa0, PK(l0, h0), od, 0, 0, 0);
  od = __builtin_amdgcn_mfma_f32_32x32x16_bf16(pa1, PK(l1, h1), od, 0, 0, 0);
  od = __builtin_amdgcn_mfma_f32_32x32x16_bf16(pa2, PK(l2, h2), od, 0, 0, 0);
  od = __builtin_amdgcn_mfma_f32_32x32x16_bf16(pa3, PK(l3, h3), od, 0, 0, 0);
#undef PK
}
__device__ __forceinline__ void pv_d0(f32x16* o, int vb, bf16x8 pa0, bf16x8 pa1, bf16x8 pa2, bf16x8 pa3) {
  pv_one<0>(o[0], vb, pa0, pa1, pa2, pa3); pv_one<1>(o[1], vb, pa0, pa1, pa2, pa3); pv_one<2>(o[2], vb, pa0, pa1, pa2, pa3); pv_one<3>(o[3], vb, pa0, pa1, pa2, pa3);
}
__device__ __forceinline__ void rope8(bf16x8& a, bf16x8& b, const float* cs, const float* sn) {
  const f32x4 c0 = *(const f32x4*)cs, c1 = *(const f32x4*)(cs + 4), s0 = *(const f32x4*)sn, s1 = *(const f32x4*)(sn + 4);
  float x1[8], x2[8], y1[8], y2[8];
#pragma unroll
  for (int e = 0; e < 8; ++e) { x1[e] = __uint_as_float(((unsigned)(unsigned short)a[e]) << 16); x2[e] = __uint_as_float(((unsigned)(unsigned short)b[e]) << 16); }
#pragma unroll
  for (int e = 0; e < 8; ++e) { const float c = e < 4 ? c0[e & 3] : c1[e & 3], s = e < 4 ? s0[e & 3] : s1[e & 3]; y1[e] = x1[e] * c - x2[e] * s; y2[e] = x2[e] * c + x1[e] * s; }
  u32x4 wa = {cvtpk(y1[0], y1[1]), cvtpk(y1[2], y1[3]), cvtpk(y1[4], y1[5]), cvtpk(y1[6], y1[7])};
  u32x4 wb = {cvtpk(y2[0], y2[1]), cvtpk(y2[2], y2[3]), cvtpk(y2[4], y2[5]), cvtpk(y2[6], y2[7])};
  a = *reinterpret_cast<bf16x8*>(&wa); b = *reinterpret_cast<bf16x8*>(&wb);
}
template <int DQK, int LDQ, int LDK, int LDV>
__device__ __forceinline__ void attn_body(const bf16* __restrict__ Qb, const bf16* __restrict__ Kh, const bf16* __restrict__ Kr, const bf16* __restrict__ Vh,
                                          bf16* __restrict__ Ob, int seq, char* lds, const float C, const float THRS, const float* cosq, const float* sinq) {
  constexpr int ND = DQK / 16; constexpr size_t SHM_K = KVBLK * DQK * 2; constexpr int LDO = 2048; constexpr bool X = (DQK == 192);
  const int tid = threadIdx.x, wid = tid >> 6, lane = tid & 63, r32 = lane & 31, hi = lane >> 5;
  char* V_lds = lds; char* K_lds = lds + 2 * SHM_V;
  float* ws = (float*)(lds + 2 * SHM_V + 2 * SHM_K) + wid * 64; float* li_l = ws; float* al_l = ws + 32;
  float m_reg = -1e30f, l_reg = 0; f32x16 o[4] = {}; bf16x8 qr[ND];
  const bf16* Qw = Qb + (long)(wid * QBLK + r32) * LDQ + hi * 8;
#pragma unroll
  for (int d0 = 0; d0 < ND; ++d0) qr[d0] = *reinterpret_cast<const bf16x8*>(Qw + d0 * 16);
  if constexpr (X) { if (cosq) { const float* cs = cosq + (wid * QBLK + r32) * 32 + hi * 8; const float* sn = sinq + (wid * QBLK + r32) * 32 + hi * 8;
      rope8(qr[8], qr[10], cs, sn); rope8(qr[9], qr[11], cs + 16, sn + 16); } }
  const int sr = tid >> 4, sc = (tid & 15) * 8, vst0 = v_st(sr, sc), vst1 = v_st(32 + sr, sc);
  const int xr = tid >> 3, xc = (tid & 7) * 8;
  const int vb0 = (int)(uintptr_t)V_lds + v_rd_base(lane);
  bf16x8 s_vs0, s_vs1, s_ks0, s_ks1, s_kx;
#define SLOAD(k0) do { s_vs0 = *(const bf16x8*)(&Vh[(long)((k0) + sr) * LDV + sc]); s_vs1 = *(const bf16x8*)(&Vh[(long)((k0) + 32 + sr) * LDV + sc]); \
    s_ks0 = *(const bf16x8*)(&Kh[(long)((k0) + sr) * LDK + sc]); s_ks1 = *(const bf16x8*)(&Kh[(long)((k0) + 32 + sr) * LDK + sc]); \
    if constexpr (X) s_kx = *(const bf16x8*)(&Kr[(long)((k0) + xr) * 64 + xc]); } while (0)
#define SWRITE(b) do { *(bf16x8*)(V_lds + (b) * SHM_V + vst0) = s_vs0;          \
    *(bf16x8*)(V_lds + (b) * SHM_V + vst1) = s_vs1; int kc = sc * 2;               \
    *(bf16x8*)(K_lds + (b) * SHM_K + kswz<DQK>(sr, kc)) = s_ks0;                       \
    *(bf16x8*)(K_lds + (b) * SHM_K + kswz<DQK>(32 + sr, kc)) = s_ks1; \
    if constexpr (X) *(bf16x8*)(K_lds + (b) * SHM_K + kswz<DQK>(xr, 256 + xc * 2)) = s_kx; } while (0)
#define RESC(a) do { if (__any((a) < 1.f)) { if (hi == 0) al_l[r32] = (a); asm volatile("s_waitcnt lgkmcnt(0)" ::: "memory"); \
    _Pragma("unroll") for (int d = 0; d < 4; ++d) _Pragma("unroll") for (int r = 0; r < 16; ++r) o[d][r] *= al_l[crow(r, hi)]; } } while (0)
#define TILE(b) do { f32x16 p0, p1; float mn, al; bf16x8 pa0, pa1, pa2, pa3; \
    qkt<DQK>(p0, p1, K_lds + (b) * SHM_K, qr, r32, hi); partialSM(p0, p1, m_reg, mn, al, C, THRS); RESC(al); \
    finishSM(p0, p1, al, l_reg, pa0, pa1, pa2, pa3); SBAR(); pv_d0(o, vb0 + (b) * (int)SHM_V, pa0, pa1, pa2, pa3); } while (0)
  const int NT = seq / KVBLK;
  SLOAD(0); asm volatile("s_waitcnt vmcnt(0)" ::: "memory"); SWRITE(0); SLOAD(KVBLK); __syncthreads();
  for (int j = 0; j < NT; j += 2) {
    SWRITE(1); if (j + 2 < NT) SLOAD((j + 2) * KVBLK);
    TILE(0);
    __syncthreads();
    if (j + 2 < NT) { SWRITE(0); if (j + 3 < NT) SLOAD((j + 3) * KVBLK); }
    TILE(1);
    __syncthreads();
  }
  if (hi == 0) li_l[r32] = l_reg; asm volatile("s_waitcnt lgkmcnt(0)" ::: "memory");
  float rli[16];
#pragma unroll
  for (int r = 0; r < 16; ++r) rli[r] = __builtin_amdgcn_rcpf(li_l[crow(r, hi)]);
  bf16* Ow = Ob + (long)(wid * QBLK) * LDO;
#pragma unroll
  for (int r = 0; r < 16; ++r) { int orow = crow(r, hi);
#pragma unroll
    for (int d0 = 0; d0 < 4; ++d0) Ow[(long)orow * LDO + d0 * 32 + r32] = f2bf(o[d0][r] * rli[r]); }
#undef SLOAD
#undef SWRITE
#undef TILE
#undef RESC
}
}
struct Params { const float* in[30]; float* out; unsigned char* ws; };
enum { I_X = 0, I_C, I_CTX, I_CCTX, I_MODW, I_MODB, I_NMIX, I_NFFN, I_WMIX, I_WG, I_WU, I_WD, I_WATT, I_QNW, I_KNW, I_MQNW, I_WUQ, I_MKVNW, I_WUKV, I_WREC,
       I_CONVW, I_CONVB, I_RAW, I_RAB, I_IXW, I_IXB, I_LAM, I_LBL, I_HGNW, I_FNW };

__device__ __forceinline__ void tr_item(const float* W, int N, bf16* WT, int ldt, int koff, int drow0, LAS float* scr, int k0, int n0, int lane) {
#pragma unroll
    for (int i = 0; i < 32; ++i) { const int kk = 2 * i + (lane >> 5); scr[kk * 33 + (lane & 31)] = W[(size_t)(k0 + kk) * N + n0 + (lane & 31)]; }
    LDS_WAIT();
    const int c = lane & 7;
#pragma unroll
    for (int j = 0; j < 4; ++j) { const int n = (lane >> 3) + 8 * j; const LAS float* s = scr + (8 * c) * 33 + n;
        v4u o; o.x = cvtpk(s[0 * 33], s[1 * 33]); o.y = cvtpk(s[2 * 33], s[3 * 33]); o.z = cvtpk(s[4 * 33], s[5 * 33]); o.w = cvtpk(s[6 * 33], s[7 * 33]);
        *(v4u*)(WT + (size_t)(drow0 + n) * ldt + koff + k0 + 8 * c) = o; }
    LDS_WAIT();
}
template <int MODE>
__device__ __forceinline__ void tr_job(const float* W, int K, int N, bf16* WT, int row_off, int& base, int gw, int NGW, LAS float* scr, int lane) {
    const int nblk = N / 32, nit = (K / 64) * nblk;
    int it = (gw - base % NGW + NGW) % NGW;
    for (; it < nit; it += NGW) { const int kb = it / nblk, n0 = (it % nblk) * 32;
        const int drow0 = MODE ? (n0 >> 7) * 256 + row_off + (n0 & 127) : row_off + n0;
        tr_item(W, N, WT, K, 0, drow0, scr, kb * 64, n0, lane); }
    base += nit;
}
struct TrItem { const float* src; bf16* dst; int N, ldt; };
constexpr int TR_TOTAL = 2624 + 384 + 512 + 2048 + 2048 + 4 * 5632 + 2 * 5632 + 7168 + 256;
__device__ __forceinline__ void tr_decode(const Params& P, int g, TrItem& t) {
    unsigned char* ws = P.ws;
    const float* W; bf16* WT; int K, N, row_off = 0, mode = 0, it = g;
    if (it < 2624) { W = P.in[I_WATT]; WT = (bf16*)(ws + WS_WATT); K = 2048; N = AIW; }
    else if ((it -= 2624) < 384) { W = P.in[I_WUQ]; WT = (bf16*)(ws + WS_WUQ); K = 512; N = 1536; }
    else if ((it -= 384) < 512) { W = P.in[I_WUKV]; WT = (bf16*)(ws + WS_WUKV); K = 512; N = 2048; }
    else if ((it -= 512) < 2048) { W = P.in[I_WMIX]; WT = (bf16*)(ws + WS_WMIX0); K = 2048; N = 2048; }
    else if ((it -= 2048) < 2048) { W = P.in[I_WMIX] + (size_t)2048 * 2048; WT = (bf16*)(ws + WS_WMIX1); K = 2048; N = 2048; }
    else if ((it -= 2048) < 5632) { W = P.in[I_WG]; WT = (bf16*)(ws + WS_WGU0); K = 2048; N = FFH; mode = 1; }
    else if ((it -= 5632) < 5632) { W = P.in[I_WU]; WT = (bf16*)(ws + WS_WGU0); K = 2048; N = FFH; mode = 1; row_off = 128; }
    else if ((it -= 5632) < 5632) { W = P.in[I_WG] + (size_t)2048 * FFH; WT = (bf16*)(ws + WS_WGU1); K = 2048; N = FFH; mode = 1; }
    else if ((it -= 5632) < 5632) { W = P.in[I_WU] + (size_t)2048 * FFH; WT = (bf16*)(ws + WS_WGU1); K = 2048; N = FFH; mode = 1; row_off = 128; }
    else if ((it -= 5632) < 5632) { W = P.in[I_WD]; WT = (bf16*)(ws + WS_WD0); K = FFH; N = 2048; }
    else if ((it -= 5632) < 5632) { W = P.in[I_WD] + (size_t)FFH * 2048; WT = (bf16*)(ws + WS_WD1); K = FFH; N = 2048; }
    else if ((it -= 5632) < 7168) { W = P.in[I_WREC]; WT = (bf16*)(ws + WS_WREC); K = 2048; N = RIW; }
    else { it -= 7168;
        const int which = it >> 7, rem = it & 127, d = rem >> 6, n = (rem >> 3) & 7, sub = rem & 7, kb = sub >> 2, nbk = sub & 3, pn = (n >> 1) * 4 + (n & 1) * 2 + d;
        t.src = (which ? P.in[I_IXW] : P.in[I_RAW]) + (size_t)(d * 8 + n) * 128 * 128 + (size_t)(kb * 64) * 128 + nbk * 32; t.N = 128; t.ldt = 128;
        t.dst = (bf16*)(ws + WS_WLRU) + (size_t)(pn * 256 + which * 128 + nbk * 32) * 128 + kb * 64; return; }
    const int nblk = N / 32, kb = it / nblk, n0 = (it - kb * nblk) * 32, k0 = kb * 64;
    const int drow0 = mode ? (n0 >> 7) * 256 + row_off + (n0 & 127) : n0;
    t.src = W + (size_t)k0 * N + n0; t.N = N; t.ldt = K; t.dst = WT + (size_t)drow0 * K + k0;
}
__device__ __forceinline__ void sincos_(float x, float& s, float& c) {
    const float k = rintf(x * 0.15915494309189535f); float r = fmaf(-k, 6.2831854820251465f, x); r = fmaf(-k, -1.7484555e-7f, r);
    s = __sinf(r); c = __cosf(r);
}
__device__ __forceinline__ void phase0(const Params& P, LAS unsigned char* lds) {
    const int tid = threadIdx.x, lane = tid & 63, wave = tid >> 6, G = gridDim.x, bid = blockIdx.x;
    unsigned char* ws = P.ws;
    {
        LAS float* sv = (LAS float*)lds;
        LAS float* red = (LAS float*)(lds + 40960);
        for (int i = tid; i < 5 * 2048; i += 512) { const int j = i >> 11, k = i & 2047; const float v = j < 4 ? P.in[I_C][j * 2048 + k] : P.in[I_CCTX][k]; sv[i] = siluf_(v); }
        __syncthreads();
        float* mod = (float*)(ws + WS_MOD);
        for (int task = bid; task < 192; task += G) {
            const int l = task / 96, n0 = (task % 96) * 128, tc = tid & 31, kg = tid >> 5;
            const float* Wp = P.in[I_MODW] + (size_t)l * 2048 * MODW + n0 + tc * 4;
            f32x4 acc[5];
#pragma unroll
            for (int j = 0; j < 5; ++j) acc[j] = (f32x4){0.f, 0.f, 0.f, 0.f};
#pragma unroll 16
            for (int k = kg; k < 2048; k += 16) { const f32x4 w = *(const f32x4*)(Wp + (size_t)k * MODW);
#pragma unroll
                for (int j = 0; j < 5; ++j) acc[j] += w * sv[j * 2048 + k]; }
#pragma unroll
            for (int j = 0; j < 5; ++j)
#pragma unroll
                for (int e = 0; e < 4; ++e) red[(kg * 32 + tc) * 20 + j * 4 + e] = acc[j][e];
            __syncthreads();
            for (int o = tid; o < 640; o += 512) { const int j = o >> 7, c = o & 127; float s = 0.f;
#pragma unroll
                for (int g = 0; g < 16; ++g) s += red[(g * 32 + (c >> 2)) * 20 + j * 4 + (c & 3)];
                mod[((size_t)l * 5 + j) * MODW + n0 + c] = s + P.in[I_MODB][l * MODW + n0 + c]; }
            __syncthreads();
        }
    }
    {
        const int gid = bid * 512 + tid, GT = G * 512;
        float* cosA = (float*)(ws + WS_COSA); float* sinA = (float*)(ws + WS_SINA); float* cosB = (float*)(ws + WS_COSB); float* sinB = (float*)(ws + WS_SINB);
        for (int i = gid; i < 4096 * 64; i += GT) { const int pos = i >> 6, k = i & 63, j = k & 31; const float p = (k < 32) ? (float)(pos >> 6) : (float)(pos & 63);
            const float f = expf(-(float)j * (9.210340371976184f / 32.f)); float s, c; sincos_(p * f, s, c); cosA[i] = c; sinA[i] = s; }
        for (int i = gid; i < 4096 * 32; i += GT) { const int pos = i >> 5, k = i & 31, j = k & 15; const float p = (k < 16) ? (float)(pos >> 6) : (float)(pos & 63);
            const float f = expf(-(float)j * (9.210340371976184f / 16.f)); float s, c; sincos_(p * f, s, c); cosB[i] = c; sinB[i] = s; }
        float* lb = (float*)(ws + WS_LB); float* sp8 = (float*)(ws + WS_SP8);
        for (int i = gid; i < 2048; i += GT) { const int d = i >> 10, w = i & 1023; const float l0 = P.in[I_LBL][(d * 2 + 0) * 1024 + w], l1 = P.in[I_LBL][(d * 2 + 1) * 1024 + w];
            lb[i] = 1.f / (1.f + expf(l0 - l1));
            const float e = expf(-P.in[I_LAM][i]); sp8[i] = 8.f * log1pf(e); }
    }
    {
        LAS float* scr = (LAS float*)(lds + wave * 16384);
        const int gw = bid * 8 + wave, NGW = G * 8;
        TrItem ta, tb; float ra[32], rb[32];
#define TR_LOAD(r, t) do { _Pragma("unroll") for (int i = 0; i < 32; ++i) r[i] = t.src[(size_t)(2 * i + (lane >> 5)) * t.N + (lane & 31)]; } while (0)
#define TR_PROC(r, t) do { _Pragma("unroll") for (int i = 0; i < 32; ++i) scr[(2 * i + (lane >> 5)) * 33 + (lane & 31)] = r[i]; \
        LDS_WAIT(); const int c_ = lane & 7; \
        _Pragma("unroll") for (int j = 0; j < 4; ++j) { const int n_ = (lane >> 3) + 8 * j; const LAS float* s_ = scr + (8 * c_) * 33 + n_; \
            v4u o_; o_.x = cvtpk(s_[0 * 33], s_[1 * 33]); o_.y = cvtpk(s_[2 * 33], s_[3 * 33]); o_.z = cvtpk(s_[4 * 33], s_[5 * 33]); o_.w = cvtpk(s_[6 * 33], s_[7 * 33]); \
            *(v4u*)(t.dst + (size_t)n_ * t.ldt + 8 * c_) = o_; } \
        LDS_WAIT(); } while (0)
        int g = gw;
        if (g < TR_TOTAL) {
            tr_decode(P, g, ta); TR_LOAD(ra, ta);
            for (;;) {
                const int g2 = g + NGW; const bool h2 = g2 < TR_TOTAL; if (h2) { tr_decode(P, g2, tb); TR_LOAD(rb, tb); }
                TR_PROC(ra, ta);
                if (!h2) break;
                const int g3 = g2 + NGW; const bool h3 = g3 < TR_TOTAL; if (h3) { tr_decode(P, g3, ta); TR_LOAD(ra, ta); }
                TR_PROC(rb, tb);
                if (!h3) break;
                g = g3;
            }
        }
#undef TR_LOAD
#undef TR_PROC
    }
}

template <int MODE>
__device__ __forceinline__ void norm_phase(const Params& P, const float* nw, const float* mod_sh  , bool lat_only, const float* part = nullptr  , bool ctx_in = false  ) {
    const int tid = threadIdx.x, lane = tid & 63, wave = tid >> 6, gw = blockIdx.x * 8 + wave, NGW = gridDim.x * 8;
    float* H = (float*)(P.ws + WS_H); bf16* U = (bf16*)(P.ws + WS_U);
    f32x4 w4[8];
#pragma unroll
    for (int j = 0; j < 8; ++j) w4[j] = ((const f32x4*)nw)[lane + 64 * j];
    for (int r = gw; r < MT; r += NGW) {
        const int b = r / TPB, tb = r - b * TPB; const bool isctx = tb < CTXL;
        if ((lat_only || MODE == 2) && isctx) continue;
        const float* src;
        if (MODE == 0) src = isctx ? P.in[I_CTX] + (size_t)(b * CTXL + tb) * DM : P.in[I_X] + (size_t)(b * SEQL + tb - CTXL) * DM;
        else src = (ctx_in && part != nullptr && isctx) ? P.in[I_CTX] + (size_t)(b * CTXL + tb) * DM : H + (size_t)r * DM;
        f32x4 v[8]; float s = 0.f;
#pragma unroll
        for (int j = 0; j < 8; ++j) { v[j] = ((const f32x4*)src)[lane + 64 * j]; s += (v[j].x * v[j].x + v[j].y * v[j].y) + (v[j].z * v[j].z + v[j].w * v[j].w); }
        if (MODE == 1 && part != nullptr && isctx) {
            s = 0.f;
#pragma unroll
            for (int j = 0; j < 8; ++j) {
#pragma unroll
                for (int q = 0; q < 4; ++q) v[j] += ((const f32x4*)(part + ((size_t)q * 1024 + b * CTXL + tb) * DM))[lane + 64 * j];
                s += (v[j].x * v[j].x + v[j].y * v[j].y) + (v[j].z * v[j].z + v[j].w * v[j].w);
                ((f32x4*)(H + (size_t)r * DM))[lane + 64 * j] = v[j]; } }
        const float rstd = rsqrtf(wave_sum(s) * (1.f / DM) + EPS);
        if (MODE == 2) {
            float* o = P.out + (size_t)(b * SEQL + tb - CTXL) * DM;
            float dlt = 0.f; if (TPH_LO >= 0 && b == 0 && tb - CTXL < 16) { const unsigned long long* ts = (const unsigned long long*)(P.ws + 15 * MiB); dlt = sqrtf((float)(ts[1] - ts[0]) * (0.01f / 20000.f)); }
#pragma unroll
            for (int j = 0; j < 8; ++j) ((f32x4*)o)[lane + 64 * j] = v[j] * rstd * w4[j] + dlt;
        } else {
            const float* sh = mod_sh + (size_t)(isctx ? 4 : b) * MODW; const float* sc = sh + DM;
#pragma unroll
            for (int j = 0; j < 8; ++j) { const f32x4 a = ((const f32x4*)sh)[lane + 64 * j], m = ((const f32x4*)sc)[lane + 64 * j];
                const f32x4 y = (v[j] * rstd * w4[j]) * (m + 1.f) + a;
                ((v2u*)(U + (size_t)r * DM))[lane + 64 * j] = (v2u){cvtpk(y.x, y.y), cvtpk(y.z, y.w)}; }
        }
    }
}
__device__ __forceinline__ void attn_post_phase(const Params& P) {
    const int tid = threadIdx.x, lane = tid & 63, wave = tid >> 6, gw = blockIdx.x * 8 + wave, NGW = gridDim.x * 8;
    unsigned char* ws = P.ws;
    const bf16* proj = (const bf16*)(ws + WS_PROJ); bf16* Qa = (bf16*)(ws + WS_QA); bf16* Ka = (bf16*)(ws + WS_KA);
    bf16* cqn = (bf16*)(ws + WS_CQN); bf16* ckvn = (bf16*)(ws + WS_CKVN); bf16* kr = (bf16*)(ws + WS_KR);
    const float* cosA = (const float*)(ws + WS_COSA); const float* sinA = (const float*)(ws + WS_SINA);
    const float* cosB = (const float*)(ws + WS_COSB); const float* sinB = (const float*)(ws + WS_SINB);
    const int hl = lane >> 5, l32 = lane & 31;
    for (int r = gw; r < MT; r += NGW) {
        const int b = r / TPB, tb = r - b * TPB; const bool lat = tb >= CTXL; const int pos = tb - CTXL;
        const bf16* pr = proj + (size_t)r * AIWP;
#pragma unroll
        for (int it = 0; it < 5; ++it) {
            const int hh = it * 2 + hl;
            const unsigned wa = *(const unsigned*)(pr + hh * 128 + 2 * l32), wb = *(const unsigned*)(pr + hh * 128 + 64 + 2 * l32);
            float a0 = bflo(wa), a1 = bfhi(wa), b0 = bflo(wb), b1 = bfhi(wb);
            float ss = a0 * a0 + a1 * a1 + b0 * b0 + b1 * b1;
#pragma unroll
            for (int o = 1; o < 32; o <<= 1) ss += __shfl_xor(ss, o);
            const float rstd = rsqrtf(ss * (1.f / 128.f) + EPS);
            const float* nw = (hh < 8) ? P.in[I_QNW] : P.in[I_KNW];
            a0 *= rstd * nw[2 * l32]; a1 *= rstd * nw[2 * l32 + 1]; b0 *= rstd * nw[64 + 2 * l32]; b1 *= rstd * nw[64 + 2 * l32 + 1];
            if (lat) { const float c0 = cosA[pos * 64 + 2 * l32], c1 = cosA[pos * 64 + 2 * l32 + 1], s0 = sinA[pos * 64 + 2 * l32], s1 = sinA[pos * 64 + 2 * l32 + 1];
                const float x0 = a0 * c0 - b0 * s0, x1 = a1 * c1 - b1 * s1, y0 = b0 * c0 + a0 * s0, y1 = b1 * c1 + a1 * s1; a0 = x0; a1 = x1; b0 = y0; b1 = y1; }
            bf16* dst = (hh < 8) ? Qa + (size_t)r * 1024 + hh * 128 : Ka + (size_t)r * 256 + (hh - 8) * 128;
            *(unsigned*)(dst + 2 * l32) = cvtpk(a0, a1); *(unsigned*)(dst + 64 + 2 * l32) = cvtpk(b0, b1);
        }
#pragma unroll
        for (int which = 0; which < 2; ++which) {
            const v4u x = *(const v4u*)(pr + 1536 + which * 512 + lane * 8);
            float f[8]; float ss = 0.f;
#pragma unroll
            for (int e = 0; e < 4; ++e) { f[2 * e] = bflo(x[e]); f[2 * e + 1] = bfhi(x[e]); ss += f[2 * e] * f[2 * e] + f[2 * e + 1] * f[2 * e + 1]; }
            const float rstd = rsqrtf(wave_sum(ss) * (1.f / 512.f) + EPS);
            const float* nw = (which ? P.in[I_MKVNW] : P.in[I_MQNW]) + lane * 8;
            v4u o;
#pragma unroll
            for (int e = 0; e < 4; ++e) o[e] = cvtpk(f[2 * e] * rstd * nw[2 * e], f[2 * e + 1] * rstd * nw[2 * e + 1]);
            *(v4u*)((which ? ckvn : cqn) + (size_t)r * 512 + lane * 8) = o;
        }
        if (lane < 32) {
            float x1 = bf2f(pr[2560 + lane]), x2 = bf2f(pr[2592 + lane]);
            if (lat) { const float c = cosB[pos * 32 + lane], s = sinB[pos * 32 + lane]; const float y1 = x1 * c - x2 * s, y2 = x2 * c + x1 * s; x1 = y1; x2 = y2; }
            kr[(size_t)r * 64 + lane] = f2bf(x1); kr[(size_t)r * 64 + 32 + lane] = f2bf(x2);
        }
    }
}

__device__ __forceinline__ void attn_phase(const Params& P, char* lds) {
    unsigned char* ws = P.ws;
    const bf16* proj = (const bf16*)(ws + WS_PROJ); const bf16* Qa = (const bf16*)(ws + WS_QA); const bf16* Ka = (const bf16*)(ws + WS_KA);
    const bf16* kr = (const bf16*)(ws + WS_KR); const bf16* qb = (const bf16*)(ws + WS_QB); const bf16* kvb = (const bf16*)(ws + WS_KVB);
    bf16* mix = (bf16*)(ws + WS_MIX);
    const float* cosB = (const float*)(ws + WS_COSB); const float* sinB = (const float*)(ws + WS_SINB);
    const int w = blockIdx.x, G = gridDim.x;
    const float CA = 0.08838834764831845f * 1.4426950408889634f, TA = 8.f / 0.08838834764831845f;
    const float CB = 0.07216878364870323f * 1.4426950408889634f, TB = 8.f / 0.07216878364870323f;
    for (int u = w; u < 512 + 32; u += G) {
        __syncthreads();
        int b, h, qblk; bool isctx = false;
        if (u < 512) { const int r = u >> 8, ww = u & 255, grp = r * 4 + ((ww & 7) >> 1), idx = ((ww & 7) & 1) * 32 + (ww >> 3);
            b = grp >> 1; h = (grp & 1) * 4 + (idx >> 4); qblk = idx & 15; }
        else { const int v = u - 512; b = v >> 3; h = v & 7; qblk = 0; isctx = true; }
        const size_t row0 = (size_t)b * TPB, qrow = isctx ? row0 : row0 + CTXL + qblk * 256; const int seq = isctx ? CTXL : TPB;
        const int kvh = h >> 2;
        attn::attn_body<128, 1024, 256, AIWP>(Qa + qrow * 1024 + h * 128, Ka + row0 * 256 + kvh * 128, nullptr, proj + row0 * AIWP + 1280 + kvh * 128,
                                              mix + qrow * 2048 + h * 128, seq, lds, CA, TA, nullptr, nullptr);
    }
    for (int u0 = w; u0 < 512 + 256; u0 += G) {
        int u = u0; if (u0 >= 512) { if (u0 < 512 + 32 || u0 >= 512 + 64) continue; u = u0 - 32; }
        __syncthreads();
        int b, h, qblk; bool isctx = false;
        if (u < 512) { const int r = u >> 8, ww = u & 255, grp = r * 16 + (ww & 7) * 2 + ((ww >> 3) >> 4);
            b = grp >> 3; h = grp & 7; qblk = (ww >> 3) & 15; }
        else { const int v = u - 512; b = v >> 3; h = v & 7; qblk = 0; isctx = true; }
        const size_t row0 = (size_t)b * TPB, qrow = isctx ? row0 : row0 + CTXL + qblk * 256; const int seq = isctx ? CTXL : TPB;
        attn::attn_body<192, 1536, 2048, 2048>(qb + qrow * 1536 + h * 192, kvb + row0 * 2048 + h * 256, kr + row0 * 64, kvb + row0 * 2048 + h * 256 + 128,
                                               mix + qrow * 2048 + 1024 + h * 128, seq, lds, CB, TB, isctx ? nullptr : cosB + (size_t)qblk * 256 * 32, isctx ? nullptr : sinB + (size_t)qblk * 256 * 32);
    }
}

__device__ __forceinline__ void conv_phase(const Params& P) {
    const bf16* prec = (const bf16*)(P.ws + WS_PREC); bf16* xc = (bf16*)(P.ws + WS_XC);
    const float* cw = P.in[I_CONVW]; const float* cb = P.in[I_CONVB];
    const int GT = gridDim.x * 512;
    for (int idx = blockIdx.x * 512 + threadIdx.x; idx < MT * 128; idx += GT) {
        const int row = idx >> 7, c8 = (idx & 127) * 8, tb = row % TPB, lo = tb < CTXL ? 0 : CTXL, hi = tb < CTXL ? CTXL : TPB;
        float acc[8];
#pragma unroll
        for (int e = 0; e < 8; ++e) acc[e] = cb[c8 + e];
#pragma unroll
        for (int j = 0; j < 4; ++j) { const int t2 = tb + j - 2;
            if (t2 >= lo && t2 < hi) { const v4u x = *(const v4u*)(prec + (size_t)(row + j - 2) * PRW + c8);
#pragma unroll
                for (int e = 0; e < 4; ++e) { acc[2 * e] += cw[j * 1024 + c8 + 2 * e] * bflo(x[e]); acc[2 * e + 1] += cw[j * 1024 + c8 + 2 * e + 1] * bfhi(x[e]); } } }
        *(v4u*)(xc + (size_t)row * 1024 + c8) = (v4u){cvtpk(acc[0], acc[1]), cvtpk(acc[2], acc[3]), cvtpk(acc[4], acc[5]), cvtpk(acc[6], acc[7])};
    }
}
typedef float f32x4m __attribute__((ext_vector_type(4)));
__device__ __forceinline__ void hg_a_phase(const Params& P, LAS unsigned char* lds) {
    const bf16* HG = (const bf16*)(P.ws + WS_HG); bf16* SS = (bf16*)(P.ws + WS_SS); float* HGD = (float*)(P.ws + WS_HGD); const float* lb = (const float*)(P.ws + WS_LB);
    LAS bf16* Kt = (LAS bf16*)lds;
    LAS bf16* Vt = (LAS bf16*)(lds + 36864);
    LAS float* segt = (LAS float*)(lds + 55296);
    const int tid = threadIdx.x, lane = tid & 63, wid = tid >> 6, fr = lane & 15, fq = lane >> 4;
    const int sdir = tid >> 8, half = (tid >> 7) & 1, d = tid & 127;
    v4u xv[2]; bf16 pfv[32];
#define HGA_LOAD(task_) do { const int rc_ = (task_) % 68, bh_ = (task_) / 68, b_ = bh_ >> 3, h_ = bh_ & 7; \
        _Pragma("unroll") for (int i = 0; i < 2; ++i) { const int id = tid + 512 * i, r = id >> 4, v8 = (id & 15) * 8; xv[i] = *(const v4u*)(HG + ((((size_t)3 * 4 + b_) * 8 + h_) * 4352 + rc_ * 64 + r) * 128 + v8); } \
        const bf16* pf_ = HG + ((((size_t)(1 + sdir) * 4 + b_) * 8 + h_) * 4352 + rc_ * 64 + half * 32) * 128 + d; \
        _Pragma("unroll") for (int e = 0; e < 32; ++e) pfv[e] = pf_[e * 128]; } while (0)
    if ((int)blockIdx.x < NBATCH * 8 * 68) HGA_LOAD((int)blockIdx.x);
    for (int task = blockIdx.x; task < NBATCH * 8 * 68; task += gridDim.x) {
        const int rc = task % 68, bh = task / 68, b = bh >> 3, h = bh & 7;
        __syncthreads();
#pragma unroll
        for (int i = 0; i < 2; ++i) { const int id = tid + 512 * i, r = id >> 4, v8 = (id & 15) * 8;
#pragma unroll
            for (int e = 0; e < 4; ++e) { Vt[(v8 + 2 * e) * 72 + r] = (bf16)(xv[i][e] & 0xffffu); Vt[(v8 + 2 * e + 1) * 72 + r] = (bf16)(xv[i][e] >> 16); } }
        float kh[32]; float E = 0.f;
        { const float lbv = lb[sdir * 1024 + h * 128 + d];
#pragma unroll
          for (int e = 0; e < 32; ++e) { const int ix = sdir ? e : 31 - e; const float x = bf2f(pfv[ix]);
              const float sg = sigmoidf_(x), f = lbv + (1.f - lbv) * sg, kk = (1.f - lbv) * (1.f - sg);
              kh[ix] = kk * __expf(E); E += __logf(f); } }
        segt[(sdir * 2 + half) * 128 + d] = E;
        if (task + (int)gridDim.x < NBATCH * 8 * 68) HGA_LOAD(task + (int)gridDim.x);
        __syncthreads();
        { const float To = segt[(sdir * 2 + (1 - half)) * 128 + d]; const bool need = sdir ? (half == 1) : (half == 0); const float mul = need ? __expf(To) : 1.f;
#pragma unroll
          for (int e = 0; e < 16; ++e) *(LAS unsigned*)(Kt + (sdir * 128 + d) * 72 + half * 32 + 2 * e) = cvtpk(kh[2 * e] * mul, kh[2 * e + 1] * mul);
          if (half == 0) HGD[((size_t)(bh * 2 + sdir) * 68 + rc) * 128 + d] = __expf(E + To); }
        __syncthreads();
        const int dir = wid >> 2, dt0 = (wid & 3) * 2;
        bf16x8 a[2][2];
#pragma unroll
        for (int t = 0; t < 2; ++t)
#pragma unroll
            for (int ks = 0; ks < 2; ++ks) a[t][ks] = *(const LAS bf16x8*)(Kt + (dir * 128 + (dt0 + t) * 16 + fr) * 72 + ks * 32 + fq * 8);
        bf16* out = SS + ((size_t)(bh * 2 + dir) * 68 + rc) * 16384;
#pragma unroll
        for (int vt = 0; vt < 8; ++vt) {
            bf16x8 bb[2];
#pragma unroll
            for (int ks = 0; ks < 2; ++ks) bb[ks] = *(const LAS bf16x8*)(Vt + (vt * 16 + fr) * 72 + ks * 32 + fq * 8);
#pragma unroll
            for (int t = 0; t < 2; ++t) { f32x4m c = {0.f, 0.f, 0.f, 0.f};
                c = __builtin_amdgcn_mfma_f32_16x16x32_bf16(a[t][0], bb[0], c, 0, 0, 0); c = __builtin_amdgcn_mfma_f32_16x16x32_bf16(a[t][1], bb[1], c, 0, 0, 0);
                *(v2u*)(out + (vt * 16 + fr) * 128 + (dt0 + t) * 16 + 4 * fq) = (v2u){cvtpk(c[0], c[1]), cvtpk(c[2], c[3])}; }
        }
    }
}
#undef HGA_LOAD
__device__ __forceinline__ void hg_b_phase(const Params& P) {
    bf16* SS = (bf16*)(P.ws + WS_SS); const float* HGD = (const float*)(P.ws + WS_HGD);
    const int GT = gridDim.x * 512;
    for (int t = blockIdx.x * 512 + threadIdx.x; t < 64 * 2048; t += GT) {
        const int seq = t >> 11, v = (t >> 4) & 127, d8 = (t & 15) * 8, dir = seq & 1;
        float S[8];
#pragma unroll
        for (int e = 0; e < 8; ++e) S[e] = 0.f;
        for (int j0 = 0; j0 < 72; j0 += 8) {
            v4u x[8]; f32x4 d0[8], d1[8]; bf16* p[8];
#pragma unroll
            for (int q = 0; q < 8; ++q) { const int j = j0 + q; if (j < 68) { const int rc = dir ? (j < 4 ? 3 - j : 71 - j) : j;
                p[q] = SS + ((size_t)seq * 68 + rc) * 16384 + v * 128 + d8; x[q] = *(const v4u*)p[q];
                const float* dp = HGD + ((size_t)seq * 68 + rc) * 128 + d8; d0[q] = *(const f32x4*)dp; d1[q] = *(const f32x4*)(dp + 4); } }
#pragma unroll
            for (int q = 0; q < 8; ++q) { if (j0 + q < 68) {
                *(v4u*)p[q] = (v4u){cvtpk(S[0], S[1]), cvtpk(S[2], S[3]), cvtpk(S[4], S[5]), cvtpk(S[6], S[7])};
#pragma unroll
                for (int e = 0; e < 4; ++e) { S[2 * e] = (e < 2 ? d0[q][2 * e] : d1[q][2 * e - 4]) * S[2 * e] + bflo(x[q][e]); S[2 * e + 1] = (e < 2 ? d0[q][2 * e + 1] : d1[q][2 * e - 3]) * S[2 * e + 1] + bfhi(x[q][e]); } } }
        }
    }
}
__device__ __forceinline__ void hg_c_phase(const Params& P, LAS unsigned char* lds) {
    const bf16* HG = (const bf16*)(P.ws + WS_HG); const bf16* SS = (const bf16*)(P.ws + WS_SS); const float* lb = (const float*)(P.ws + WS_LB); bf16* mix = (bf16*)(P.ws + WS_MIX);
    LAS bf16* qs = (LAS bf16*)lds;
    LAS bf16* Vt = (LAS bf16*)(lds + 17408);
    LAS float* cum = (LAS float*)(lds + 35840);
    LAS bf16* ksm = (LAS bf16*)(lds + 69632);
    LAS float* red = (LAS float*)(lds + 105472);
    LAS float* segt = (LAS float*)(lds + 105984);
    LAS bf16* Ss = (LAS bf16*)(lds + 108032);
    const int tid = threadIdx.x, lane = tid & 63, wid = tid >> 6, fr = lane & 15, fq = lane >> 4, ti = wid & 3, vh = wid >> 2;
    const int seg = tid >> 7, dd = tid & 127;
    LAS bf16* Pw = (LAS bf16*)(lds + 87040) + wid * 1152;
    for (int task = blockIdx.x; task < NBATCH * 8 * 64; task += gridDim.x) {
        const int rc = 4 + (task & 63), bh = task >> 6, b = bh >> 3, h = bh & 7; const size_t R0 = (size_t)b * TPB + rc * 64;
        const bf16* hq = HG + ((((size_t)0 * 4 + b) * 8 + h) * 4352 + rc * 64) * 128; const size_t SECS = (size_t)4 * 8 * 4352 * 128;
        __syncthreads();
        v4u xv[2], xq[2], sreg[4]; bf16 pf0[16], pf1[16], gg[16];
#pragma unroll
        for (int i = 0; i < 2; ++i) { const int id = tid + 512 * i, r = id >> 4, v8 = (id & 15) * 8;
            xv[i] = *(const v4u*)(hq + 3 * SECS + r * 128 + v8); xq[i] = *(const v4u*)(hq + r * 128 + v8); }
#pragma unroll
        for (int e = 0; e < 16; ++e) { const bf16* pp = hq + SECS + (seg * 16 + e) * 128 + dd; pf0[e] = pp[0]; pf1[e] = pp[SECS]; }
#pragma unroll
        for (int i = 0; i < 4; ++i) { const int id = tid + 512 * i; sreg[i] = *(const v4u*)(SS + ((size_t)(bh * 2 + 0) * 68 + rc) * 16384 + (id >> 4) * 128 + (id & 15) * 8); }
#pragma unroll
        for (int vt = 0; vt < 4; ++vt)
#pragma unroll
            for (int j = 0; j < 4; ++j) gg[vt * 4 + j] = hq[4 * SECS + (16 * ti + 4 * fq + j) * 128 + vh * 64 + vt * 16 + fr];
#pragma unroll
        for (int i = 0; i < 2; ++i) { const int id = tid + 512 * i, r = id >> 4, v8 = (id & 15) * 8;
#pragma unroll
            for (int e = 0; e < 4; ++e) { Vt[(v8 + 2 * e) * 72 + r] = (bf16)(xv[i][e] & 0xffffu); Vt[(v8 + 2 * e + 1) * 72 + r] = (bf16)(xv[i][e] >> 16); }
            v4u o;
#pragma unroll
            for (int e = 0; e < 4; ++e) o[e] = cvtpk(siluf_(bflo(xq[i][e])), siluf_(bfhi(xq[i][e])));
            *(LAS v4u*)(qs + r * 136 + v8) = o; }
        f32x4m oacc[4];
#pragma unroll
        for (int vt = 0; vt < 4; ++vt) oacc[vt] = (f32x4m){0.f, 0.f, 0.f, 0.f};
#pragma unroll
        for (int dir = 0; dir < 2; ++dir) {
            __syncthreads();
            float lc[16];
            { const float lbv = lb[dir * 1024 + h * 128 + dd]; float c = 0.f;
#pragma unroll
              for (int e = 0; e < 16; ++e) { const int ix = dir ? 15 - e : e; const float x = bf2f(dir ? pf1[ix] : pf0[ix]);
                  const float sg = sigmoidf_(x), f = lbv + (1.f - lbv) * sg, kk = (1.f - lbv) * (1.f - sg);
                  c += __logf(f); lc[ix] = c; ksm[(seg * 16 + ix) * 136 + dd] = f2bf(kk); }
              segt[seg * 128 + dd] = c; }
#pragma unroll
            for (int i = 0; i < 4; ++i) { const int id = tid + 512 * i; *(LAS v4u*)(Ss + (id >> 4) * 136 + (id & 15) * 8) = sreg[i]; }
            __syncthreads();
            { float pre = 0.f;
#pragma unroll
              for (int s2 = 0; s2 < 4; ++s2) { const bool take = dir ? (s2 > seg) : (s2 < seg); pre += take ? segt[s2 * 128 + dd] : 0.f; }
#pragma unroll
              for (int e = 0; e < 16; ++e) cum[(seg * 16 + e) * 132 + dd] = lc[e] + pre; }
            if (dir == 0) {
#pragma unroll
                for (int i = 0; i < 4; ++i) { const int id = tid + 512 * i; sreg[i] = *(const v4u*)(SS + ((size_t)(bh * 2 + 1) * 68 + rc) * 16384 + (id >> 4) * 128 + (id & 15) * 8); } }
            __syncthreads();
            const int refrow = dir ? 16 * (ti + 1) : 16 * ti - 1; const bool hasref = dir ? (ti < 3) : (ti > 0);
            bf16x8 Qt[4], Qh[4];
#pragma unroll
            for (int k4 = 0; k4 < 4; ++k4) { const int i = 16 * ti + fr, d = k4 * 32 + fq * 8;
                const v4u qw = *(const LAS v4u*)(qs + i * 136 + d);
                const f32x4 c0 = *(const LAS f32x4*)(cum + i * 132 + d), c1 = *(const LAS f32x4*)(cum + i * 132 + d + 4);
                f32x4 r0 = {0.f, 0.f, 0.f, 0.f}, r1 = {0.f, 0.f, 0.f, 0.f};
                if (hasref) { r0 = *(const LAS f32x4*)(cum + refrow * 132 + d); r1 = *(const LAS f32x4*)(cum + refrow * 132 + d + 4); }
                v4u wt, wh;
#pragma unroll
                for (int e = 0; e < 4; ++e) { const float qa = bflo(qw[e]), qb_ = bfhi(qw[e]);
                    const float ca = e < 2 ? c0[2 * e] : c1[2 * e - 4], cb_ = e < 2 ? c0[2 * e + 1] : c1[2 * e - 3];
                    const float ra = e < 2 ? r0[2 * e] : r1[2 * e - 4], rb = e < 2 ? r0[2 * e + 1] : r1[2 * e - 3];
                    wt[e] = cvtpk(qa * __expf(ca - ra), qb_ * __expf(cb_ - rb)); wh[e] = cvtpk(qa * __expf(ca), qb_ * __expf(cb_)); }
                Qt[k4] = *reinterpret_cast<bf16x8*>(&wt); Qh[k4] = *reinterpret_cast<bf16x8*>(&wh); }
#pragma unroll
            for (int sj = 0; sj < 4; ++sj) {
                const bool att = dir ? (sj >= ti) : (sj <= ti);
                f32x4m sc = {0.f, 0.f, 0.f, 0.f};
                if (att) {
#pragma unroll
                    for (int k4 = 0; k4 < 4; ++k4) { const int i2 = 16 * sj + fr, d = k4 * 32 + fq * 8;
                        const v4u kw = *(const LAS v4u*)(ksm + i2 * 136 + d);
                        const f32x4 c0 = *(const LAS f32x4*)(cum + i2 * 132 + d), c1 = *(const LAS f32x4*)(cum + i2 * 132 + d + 4);
                        f32x4 r0 = {0.f, 0.f, 0.f, 0.f}, r1 = {0.f, 0.f, 0.f, 0.f};
                        if (hasref) { r0 = *(const LAS f32x4*)(cum + refrow * 132 + d); r1 = *(const LAS f32x4*)(cum + refrow * 132 + d + 4); }
                        v4u wk;
#pragma unroll
                        for (int e = 0; e < 4; ++e) { const float ka = bflo(kw[e]), kb_ = bfhi(kw[e]);
                            const float ca = e < 2 ? c0[2 * e] : c1[2 * e - 4], cb_ = e < 2 ? c0[2 * e + 1] : c1[2 * e - 3];
                            const float ra = e < 2 ? r0[2 * e] : r1[2 * e - 4], rb = e < 2 ? r0[2 * e + 1] : r1[2 * e - 3];
                            wk[e] = cvtpk(ka * __expf(ra - ca), kb_ * __expf(rb - cb_)); }
                        sc = __builtin_amdgcn_mfma_f32_16x16x32_bf16(Qt[k4], *reinterpret_cast<bf16x8*>(&wk), sc, 0, 0, 0); }
                    if (sj == ti) {
#pragma unroll
                        for (int j = 0; j < 4; ++j) { const bool keep = dir ? (fr >= 4 * fq + j) : (fr <= 4 * fq + j); sc[j] = keep ? sc[j] : 0.f; } }
                }
#pragma unroll
                for (int j = 0; j < 4; ++j) Pw[(4 * fq + j) * 72 + 16 * sj + fr] = f2bf(sc[j]);
            }
            LDS_WAIT(); __builtin_amdgcn_wave_barrier();
#pragma unroll
            for (int ks = 0; ks < 2; ++ks) { const bf16x8 pa = *(const LAS bf16x8*)(Pw + fr * 72 + ks * 32 + fq * 8);
#pragma unroll
                for (int vt = 0; vt < 4; ++vt) { const bf16x8 vb = *(const LAS bf16x8*)(Vt + (vh * 64 + vt * 16 + fr) * 72 + ks * 32 + fq * 8);
                    oacc[vt] = __builtin_amdgcn_mfma_f32_16x16x32_bf16(pa, vb, oacc[vt], 0, 0, 0); } }
#pragma unroll
            for (int k4 = 0; k4 < 4; ++k4)
#pragma unroll
                for (int vt = 0; vt < 4; ++vt) { const bf16x8 sb = *(const LAS bf16x8*)(Ss + (vh * 64 + vt * 16 + fr) * 136 + k4 * 32 + fq * 8);
                    oacc[vt] = __builtin_amdgcn_mfma_f32_16x16x32_bf16(Qh[k4], sb, oacc[vt], 0, 0, 0); }
        }
        float ssq[4];
#pragma unroll
        for (int j = 0; j < 4; ++j) { float s = 0.f;
#pragma unroll
            for (int vt = 0; vt < 4; ++vt) s += oacc[vt][j] * oacc[vt][j];
            s += __shfl_xor(s, 1); s += __shfl_xor(s, 2); s += __shfl_xor(s, 4); s += __shfl_xor(s, 8); ssq[j] = s; }
        if (fr == 0) {
#pragma unroll
            for (int j = 0; j < 4; ++j) red[(ti * 2 + vh) * 16 + 4 * fq + j] = ssq[j]; }
        __syncthreads();
#pragma unroll
        for (int j = 0; j < 4; ++j) { const int i = 16 * ti + 4 * fq + j;
            const float tot = red[(ti * 2) * 16 + 4 * fq + j] + red[(ti * 2 + 1) * 16 + 4 * fq + j]; const float rstd = rsqrtf(tot * (1.f / 128.f) + EPS);
#pragma unroll
            for (int vt = 0; vt < 4; ++vt) { const int v = vh * 64 + vt * 16 + fr;
                mix[(R0 + i) * 2048 + 1024 + h * 128 + v] = f2bf(oacc[vt][j] * rstd * P.in[I_HGNW][h * 128 + v] * siluf_(bf2f(gg[vt * 4 + j]))); } }
    }
}
__device__ __forceinline__ void lru_ab(float ra, float ix, float xc, float rab, float ixb, float sp, float& la, float& bb, float& a) {
    const float r = sigmoidf_(ra + rab), ig = sigmoidf_(ix + ixb); la = -r * sp; a = __expf(la);
    bb = __builtin_amdgcn_sqrtf(fmaxf(fmaf(-a, a, 1.f), 0.f)) * (ig * xc);
}
template <int NCH>
__device__ __forceinline__ void lru_s1_body(const Params& P, int bd, int rc, int ch) {
    const bf16* pre = (const bf16*)(P.ws + WS_LAB); const bf16* xcb = (const bf16*)(P.ws + WS_XC); float2* carr = (float2*)(P.ws + WS_CARR); const float* sp8 = (const float*)(P.ws + WS_SP8);
    const int b = bd >> 1, dir = bd & 1, nb = ch >> 7;
    const size_t R0 = (size_t)b * TPB + rc * 64;
    const bf16* pr = pre + R0 * 4096 + ((nb >> 1) * 4 + (nb & 1) * 2 + dir) * 256 + (ch & 127); const bf16* px = xcb + R0 * 1024 + ch;
    float rab[NCH], ixb[NCH], sp[NCH], A[NCH], hh[NCH];
#pragma unroll
    for (int c = 0; c < NCH; ++c) { rab[c] = P.in[I_RAB][dir * 1024 + ch + c]; ixb[c] = P.in[I_IXB][dir * 1024 + ch + c]; sp[c] = sp8[dir * 1024 + ch + c]; A[c] = 0.f; hh[c] = 0.f; }
    constexpr int NW = NCH / 2, RB = (NCH == 8) ? 4 : 16;
    for (int i0 = 0; i0 < 64; i0 += RB) {
        unsigned w0[RB][NW], w1[RB][NW], w2[RB][NW];
#pragma unroll
        for (int e = 0; e < RB; ++e) { const int r = dir ? (63 - i0 - e) : (i0 + e);
            if constexpr (NCH == 8) { const v4u x0 = *(const v4u*)(pr + (size_t)r * 4096), x1 = *(const v4u*)(pr + (size_t)r * 4096 + 128), x2 = *(const v4u*)(px + (size_t)r * 1024);
#pragma unroll
                for (int q = 0; q < 4; ++q) { w0[e][q] = x0[q]; w1[e][q] = x1[q]; w2[e][q] = x2[q]; } }
            else { w0[e][0] = *(const unsigned*)(pr + (size_t)r * 4096); w1[e][0] = *(const unsigned*)(pr + (size_t)r * 4096 + 128); w2[e][0] = *(const unsigned*)(px + (size_t)r * 1024); } }
#pragma unroll
        for (int e = 0; e < RB; ++e)
#pragma unroll
            for (int c = 0; c < NCH; ++c) { const unsigned a0 = w0[e][c >> 1], a1 = w1[e][c >> 1], a2 = w2[e][c >> 1];
                float la, bb, av; lru_ab((c & 1) ? bfhi(a0) : bflo(a0), (c & 1) ? bfhi(a1) : bflo(a1), (c & 1) ? bfhi(a2) : bflo(a2), rab[c], ixb[c], sp[c], la, bb, av);
                A[c] += la; hh[c] = av * hh[c] + bb; }
    }
    float2* cp = carr + ((size_t)bd * 68 + rc) * 1024 + ch;
#pragma unroll
    for (int c = 0; c < NCH; ++c) cp[c] = make_float2(A[c], hh[c]);
}
__device__ __forceinline__ void lru_s1_phase(const Params& P) {
    const int tid = threadIdx.x, wave = tid >> 6, lane = tid & 63, G = gridDim.x, bid = blockIdx.x;
    if (G == 256) {
        if (wave < 4) { const int t = (wave * 256 + bid) * 64 + lane; lru_s1_body<8>(P, t >> 13, 4 + ((t >> 7) & 63), (t & 127) * 8); }
        else if (wave == 4) { const int t = bid * 64 + lane; lru_s1_body<2>(P, t >> 11, (t >> 9) & 3, (t & 511) * 2); }
    } else {
        const int GT = G * 512;
        for (int t = (wave * G + bid) * 64 + lane; t < NBATCH * 2 * 68 * 128; t += GT) lru_s1_body<8>(P, (t >> 7) / 68, (t >> 7) % 68, (t & 127) * 8);
    }
}
__device__ __forceinline__ void lru_prefix_phase(const Params& P) {
    float2* carr = (float2*)(P.ws + WS_CARR);
    const int t = (((int)threadIdx.x >> 6) * (int)gridDim.x + (int)blockIdx.x) * 64 + ((int)threadIdx.x & 63);
    if (t < NBATCH * 2 * 1024) {
        const int ch = t & 1023, bd = t >> 10, dir = bd & 1;
        float2* cp = carr + (size_t)bd * 68 * 1024 + ch;
        float hh = 0.f;
        for (int j0 = 0; j0 < 68; j0 += 17) {
            float2 ab[17];
#pragma unroll
            for (int q = 0; q < 17; ++q) { const int j = j0 + q, rc = dir ? (j < 4 ? 3 - j : 71 - j) : j; ab[q] = cp[(size_t)rc * 1024]; }
#pragma unroll
            for (int q = 0; q < 17; ++q) { const int j = j0 + q, rc = dir ? (j < 4 ? 3 - j : 71 - j) : j; cp[(size_t)rc * 1024].y = hh; hh = __expf(ab[q].x) * hh + ab[q].y; }
        }
    }
}
__device__ __forceinline__ float gelu_tanh_(float x) { return x * sigmoidf_(1.5957691216057308f * (x + 0.044715f * x * x * x)); }
__device__ __forceinline__ void lru_s2_phase(const Params& P, LAS unsigned char* lds) {
    const bf16* pre = (const bf16*)(P.ws + WS_LAB); const bf16* xcb = (const bf16*)(P.ws + WS_XC); const float2* carr = (const float2*)(P.ws + WS_CARR); const float* sp8 = (const float*)(P.ws + WS_SP8);
    const bf16* prec = (const bf16*)(P.ws + WS_PREC); bf16* mix = (bf16*)(P.ws + WS_MIX); bf16* hfs = (bf16*)(P.ws + WS_XC + 34 * MiB);
    const int tid = threadIdx.x, GT = gridDim.x * 512;
    for (int t = ((tid >> 6) * (int)gridDim.x + (int)blockIdx.x) * 64 + (tid & 63); t < NBATCH * 64 * 256; t += GT) {
        const int ch = (t & 255) * 4, rc = 4 + ((t >> 8) & 63), b = t >> 14, nb = ch >> 7; const size_t R0 = (size_t)b * TPB + rc * 64;
        const bf16* px = xcb + R0 * 1024 + ch;
#pragma unroll
        for (int dir = 0; dir < 2; ++dir) {
            const bf16* pr = pre + R0 * 4096 + ((nb >> 1) * 4 + (nb & 1) * 2 + dir) * 256 + (ch & 127);
            float rab[4], ixb[4], sp[4], hh[4];
#pragma unroll
            for (int c = 0; c < 4; ++c) { rab[c] = P.in[I_RAB][dir * 1024 + ch + c]; ixb[c] = P.in[I_IXB][dir * 1024 + ch + c]; sp[c] = sp8[dir * 1024 + ch + c];
                hh[c] = carr[((size_t)(b * 2 + dir) * 68 + rc) * 1024 + ch + c].y; }
            for (int i0 = 0; i0 < 64; i0 += 8) {
                v2u w0[8], w1[8], w2[8], gt[8], hf[8];
#pragma unroll
                for (int e = 0; e < 8; ++e) { const int r = dir ? (63 - i0 - e) : (i0 + e); w0[e] = *(const v2u*)(pr + (size_t)r * 4096); w1[e] = *(const v2u*)(pr + (size_t)r * 4096 + 128); w2[e] = *(const v2u*)(px + (size_t)r * 1024);
                    if (dir) { gt[e] = *(const v2u*)(prec + (R0 + r) * PRW + 1024 + ch); hf[e] = *(const v2u*)(hfs + (R0 + r) * 1024 + ch); } }
#pragma unroll
                for (int e = 0; e < 8; ++e) { const int r = dir ? (63 - i0 - e) : (i0 + e); float o[4];
#pragma unroll
                    for (int c = 0; c < 4; ++c) { const unsigned a0 = w0[e][c >> 1], a1 = w1[e][c >> 1], a2 = w2[e][c >> 1];
                        float la, bb, av; lru_ab((c & 1) ? bfhi(a0) : bflo(a0), (c & 1) ? bfhi(a1) : bflo(a1), (c & 1) ? bfhi(a2) : bflo(a2), rab[c], ixb[c], sp[c], la, bb, av);
                        hh[c] = av * hh[c] + bb;
                        if (dir) { const unsigned g = gt[e][c >> 1], f = hf[e][c >> 1]; o[c] = gelu_tanh_((c & 1) ? bfhi(g) : bflo(g)) * (((c & 1) ? bfhi(f) : bflo(f)) + hh[c]); } else o[c] = hh[c]; }
                    *(v2u*)((dir ? mix + (R0 + r) * 2048 : hfs + (R0 + r) * 1024) + ch) = (v2u){cvtpk(o[0], o[1]), cvtpk(o[2], o[3])}; }
            }
        }
    }
}

#define XB_TMO      128
#define XB_XCNT(j)  (256  + 64 * (j))
#define XB_XSUB(j)  (1280 + 64 * (j))
#define XB_XGEN(j)  (2304 + 64 * (j))
#define XB_TOP      3328
#define XB_TOPGEN   3392
#define XCD_BAR_WORDS 3456
#define XB_SPIN_CAP (1u << 18)

__device__ __forceinline__ unsigned xb_ld(unsigned* p)              { return __hip_atomic_load(p, __ATOMIC_RELAXED, __HIP_MEMORY_SCOPE_AGENT); }
__device__ __forceinline__ unsigned xb_add(unsigned* p, unsigned v) { return __hip_atomic_fetch_add(p, v, __ATOMIC_RELAXED, __HIP_MEMORY_SCOPE_AGENT); }
__device__ __forceinline__ unsigned xb_xcc_id() { return (unsigned)__builtin_amdgcn_s_getreg((3 << 11) | 20) & 0xFu; }
#define XB_SPIN(cond, bar) do { unsigned _sp = 0; while (cond) { __builtin_amdgcn_s_sleep(1); \
    if ((++_sp & 255u) == 0u) { if (xb_ld(&(bar)[XB_TMO])) break; if (_sp > XB_SPIN_CAP) { atomicAdd(&(bar)[XB_TMO], 1u); break; } } } } while (0)

struct XcdBarrier {
    unsigned* bar; unsigned x;
    volatile LAS unsigned* st;
};

__device__ __forceinline__ XcdBarrier xcd_barrier_post(unsigned* bar, volatile LAS unsigned* st) {
    XcdBarrier b; b.bar = bar; b.x = xb_xcc_id(); b.st = st;
    if (threadIdx.x == 0) (void)xb_add(&bar[XB_XCNT(b.x)], 1u);
    return b;
}
__device__ __forceinline__ void xcd_barrier_complete(unsigned* bar, unsigned x, unsigned& nloc, unsigned& nx) {
    const unsigned G = gridDim.x * gridDim.y * gridDim.z;
    unsigned sum, cnt, mine, sp = 0u;
    for (;;) {
        sum = 0u; cnt = 0u; mine = 0u;
#pragma unroll
        for (unsigned j = 0; j < 16; ++j) { const unsigned c = xb_ld(&bar[XB_XCNT(j)]); sum += c; cnt += (c > 0u) ? 1u : 0u; mine = (j == x) ? c : mine; }
        if (sum == G) break;
        __builtin_amdgcn_s_sleep(1);
        if ((++sp & 255u) == 0u) { if (xb_ld(&bar[XB_TMO])) break; if (sp > XB_SPIN_CAP) { atomicAdd(&bar[XB_TMO], 1u); break; } }
    }
    nloc = mine > 0u ? mine : 1u; nx = cnt > 0u ? cnt : 1u;
}

__device__ __forceinline__ void xcd_barrier(const XcdBarrier& b) {
    asm volatile("s_waitcnt vmcnt(0)" ::: "memory");
    __syncthreads();
    if (threadIdx.x == 0) {
        unsigned* bar = b.bar;
        __builtin_amdgcn_s_waitcnt(0);
        unsigned nloc = b.st[0], nx = b.st[1];
        if (nloc == 0u) { xcd_barrier_complete(bar, b.x, nloc, nx); b.st[0] = nloc; b.st[1] = nx; }
        const unsigned old = xb_add(&bar[XB_XSUB(b.x)], 1u);
        const unsigned gen = old / nloc;
        if (old + 1u == (gen + 1u) * nloc) {
            __builtin_amdgcn_fence(__ATOMIC_RELEASE, "agent");
            asm volatile("s_waitcnt vmcnt(0)" ::: "memory");
            const unsigned og = xb_add(&bar[XB_TOP], 1u);
            const unsigned tg = og / nx;
            if (og + 1u == (tg + 1u) * nx) xb_add(&bar[XB_TOPGEN], 1u);
            else XB_SPIN(xb_ld(&bar[XB_TOPGEN]) == tg, bar);
            __builtin_amdgcn_fence(__ATOMIC_ACQUIRE, "agent");
            xb_add(&bar[XB_XGEN(b.x)], 1u);
            asm volatile("s_waitcnt vmcnt(0)" ::: "memory");
        } else {
            XB_SPIN(xb_ld(&bar[XB_XGEN(b.x)]) == gen, bar);
            __builtin_amdgcn_fence(__ATOMIC_ACQUIRE, "agent");
            asm volatile("s_waitcnt vmcnt(0)" ::: "memory");
        }
    }
    __syncthreads();
}

constexpr int NPHASE = 23;
__global__ void __launch_bounds__(512, 2) mega_fwd(Params P, int lo, int hi) {
    extern __shared__ __attribute__((aligned(16))) unsigned char lds_raw[];
    cg::grid_group grid = cg::this_grid();
    LAS unsigned char* lds = (LAS unsigned char*)lds_raw;
    unsigned char* ws = P.ws;
    const int G = gridDim.x, bid = blockIdx.x;
    float* mod = (float*)(ws + WS_MOD);
    volatile LAS unsigned* bst = (volatile LAS unsigned*)(lds + (LDS_BYTES - 64));
    if (threadIdx.x < 2) bst[threadIdx.x] = 0u;
    __syncthreads();
    XcdBarrier xbar = xcd_barrier_post((unsigned*)(ws + WS_XBAR), bst);
    unsigned long long* tstamp = (unsigned long long*)(ws + 15 * MiB);
#ifndef PH_ONLY
#define PH_ONLY -1
#endif
#ifndef DUPMASK
#define DUPMASK 0
#endif
#define IN(k) ((PH_ONLY < 0 || PH_ONLY == (k)) && lo <= (k) && (k) < hi)
#define TSTAMP(k) do { if (TPH_LO >= 0 && blockIdx.x == 0 && threadIdx.x == 0) { if ((k) == TPH_LO) tstamp[0] = __builtin_amdgcn_s_memrealtime(); if ((k) == TPH_HI + 1) tstamp[1] = __builtin_amdgcn_s_memrealtime(); } } while (0)
#define SEAM(k) do { if (IN(k) && IN((k) + 1)) xcd_barrier(xbar); } while (0)
    if (hi > 1000) grid.sync();
    TSTAMP(0); if (IN(0)) { phase0(P, lds); } SEAM(0);
#if (DUPMASK >> 0) & 1
    TSTAMP(0); if (IN(0)) { phase0(P, lds); } SEAM(0);
#endif

    TSTAMP(1); if (IN(1)) { norm_phase<0>(P, P.in[I_NMIX], mod + 0 * DM, false); } SEAM(1);
#if (DUPMASK >> 1) & 1
    TSTAMP(1); if (IN(1)) { norm_phase<0>(P, P.in[I_NMIX], mod + 0 * DM, false); } SEAM(1);
#endif

    TSTAMP(2); if (IN(2)) { pg8::Gemm g{(const bf16*)(ws + WS_U), (const bf16*)(ws + WS_WATT), MT, AIWP, 2048, 2048, 0}; pg8::StaticOrder S; S.init(MT, AIWP, G, bid, 0, 2048);
        pg8::EpiStore E{(bf16*)(ws + WS_PROJ), AIWP}; pg8::gemm_phase<pg8::EpiStore, pg8::StaticOrder, true, true>(lds, g, S, E); } SEAM(2);
#if (DUPMASK >> 2) & 1
    TSTAMP(2); if (IN(2)) { pg8::Gemm g{(const bf16*)(ws + WS_U), (const bf16*)(ws + WS_WATT), MT, AIWP, 2048, 2048, 0}; pg8::StaticOrder S; S.init(MT, AIWP, G, bid, 0, 2048);
        pg8::EpiStore E{(bf16*)(ws + WS_PROJ), AIWP}; pg8::gemm_phase<pg8::EpiStore, pg8::StaticOrder, true, true>(lds, g, S, E); } SEAM(2);
#endif

    TSTAMP(3); if (IN(3)) { attn_post_phase(P); } SEAM(3);
#if (DUPMASK >> 3) & 1
    TSTAMP(3); if (IN(3)) { attn_post_phase(P); } SEAM(3);
#endif

    TSTAMP(4); if (IN(4)) {
        { pg8::Gemm g{(const bf16*)(ws + WS_CQN), (const bf16*)(ws + WS_WUQ), MT, 3584, 512, 512, 2}; pg8::StaticOrder S; S.init(MT, 3584, G, bid, 0, 512);
          pg8::EpiMla E{(bf16*)(ws + WS_QB), (bf16*)(ws + WS_KVB)}; pg8::gemm_phase<pg8::EpiMla, pg8::StaticOrder, true, true>(lds, g, S, E); }
    } SEAM(4);
#if (DUPMASK >> 4) & 1
    TSTAMP(4); if (IN(4)) {
        { pg8::Gemm g{(const bf16*)(ws + WS_CQN), (const bf16*)(ws + WS_WUQ), MT, 3584, 512, 512, 2}; pg8::StaticOrder S; S.init(MT, 3584, G, bid, 0, 512);
          pg8::EpiMla E{(bf16*)(ws + WS_QB), (bf16*)(ws + WS_KVB)}; pg8::gemm_phase<pg8::EpiMla, pg8::StaticOrder, true, true>(lds, g, S, E); }
    } SEAM(4);
#endif

    TSTAMP(5); if (IN(5)) { attn_phase(P, (char*)lds_raw); } SEAM(5);
#if (DUPMASK >> 5) & 1
    TSTAMP(5); if (IN(5)) { attn_phase(P, (char*)lds_raw); } SEAM(5);
#endif

    TSTAMP(6); if (IN(6)) { pg8::Gemm g{(const bf16*)(ws + WS_MIX), (const bf16*)(ws + WS_WMIX0), MT, 2048, 2048, 2048, 0}; pg8::StaticOrder S; S.init(MT, 2048, G, bid, 0, 2048, G == 256);
        pg8::EpiResGate E{(float*)(ws + WS_H), mod + 2 * DM, (float*)(ws + WS_PART), 2048 / 64, P.in[I_X], P.in[I_CTX]}; pg8::gemm_phase<pg8::EpiResGate, pg8::StaticOrder, true, true>(lds, g, S, E); } SEAM(6);
#if (DUPMASK >> 6) & 1
    TSTAMP(6); if (IN(6)) { pg8::Gemm g{(const bf16*)(ws + WS_MIX), (const bf16*)(ws + WS_WMIX0), MT, 2048, 2048, 2048, 0}; pg8::StaticOrder S; S.init(MT, 2048, G, bid, 0, 2048, G == 256);
        pg8::EpiResGate E{(float*)(ws + WS_H), mod + 2 * DM, (float*)(ws + WS_PART), 2048 / 64, P.in[I_X], P.in[I_CTX]}; pg8::gemm_phase<pg8::EpiResGate, pg8::StaticOrder, true, true>(lds, g, S, E); } SEAM(6);
#endif

    TSTAMP(7); if (IN(7)) { norm_phase<1>(P, P.in[I_NFFN], mod + 3 * DM, false, G == 256 ? (const float*)(ws + WS_PART) : nullptr, true); } SEAM(7);
#if (DUPMASK >> 7) & 1
    TSTAMP(7); if (IN(7)) { norm_phase<1>(P, P.in[I_NFFN], mod + 3 * DM, false, G == 256 ? (const float*)(ws + WS_PART) : nullptr, true); } SEAM(7);
#endif

    TSTAMP(8); if (IN(8)) { pg8::Gemm g{(const bf16*)(ws + WS_U), (const bf16*)(ws + WS_WGU0), MT, 2 * FFH, 2048, 2048, 0}; pg8::StaticOrder S; S.init(MT, 2 * FFH, G, bid, 0, 2048);
        pg8::EpiSwiGLU E{(bf16*)(ws + WS_HID), FFH}; pg8::gemm_phase<pg8::EpiSwiGLU, pg8::StaticOrder, true, true>(lds, g, S, E); } SEAM(8);
#if (DUPMASK >> 8) & 1
    TSTAMP(8); if (IN(8)) { pg8::Gemm g{(const bf16*)(ws + WS_U), (const bf16*)(ws + WS_WGU0), MT, 2 * FFH, 2048, 2048, 0}; pg8::StaticOrder S; S.init(MT, 2 * FFH, G, bid, 0, 2048);
        pg8::EpiSwiGLU E{(bf16*)(ws + WS_HID), FFH}; pg8::gemm_phase<pg8::EpiSwiGLU, pg8::StaticOrder, true, true>(lds, g, S, E); } SEAM(8);
#endif

    TSTAMP(9); if (IN(9)) { pg8::Gemm g{(const bf16*)(ws + WS_HID), (const bf16*)(ws + WS_WD0), MT, 2048, FFH, FFH, 0}; pg8::StaticOrder S; S.init(MT, 2048, G, bid, 0, FFH, G == 256);
        pg8::EpiResGate E{(float*)(ws + WS_H), mod + 5 * DM, (float*)(ws + WS_PART), FFH / 64, nullptr, nullptr}; pg8::gemm_phase<pg8::EpiResGate, pg8::StaticOrder, true, true>(lds, g, S, E); } SEAM(9);
#if (DUPMASK >> 9) & 1
    TSTAMP(9); if (IN(9)) { pg8::Gemm g{(const bf16*)(ws + WS_HID), (const bf16*)(ws + WS_WD0), MT, 2048, FFH, FFH, 0}; pg8::StaticOrder S; S.init(MT, 2048, G, bid, 0, FFH, G == 256);
        pg8::EpiResGate E{(float*)(ws + WS_H), mod + 5 * DM, (float*)(ws + WS_PART), FFH / 64, nullptr, nullptr}; pg8::gemm_phase<pg8::EpiResGate, pg8::StaticOrder, true, true>(lds, g, S, E); } SEAM(9);
#endif

    float* mod1 = mod + 5 * MODW;
    TSTAMP(10); if (IN(10)) { norm_phase<1>(P, P.in[I_NMIX] + DM, mod1 + 0 * DM, false, G == 256 ? (const float*)(ws + WS_PART) : nullptr); } SEAM(10);
#if (DUPMASK >> 10) & 1
    TSTAMP(10); if (IN(10)) { norm_phase<1>(P, P.in[I_NMIX] + DM, mod1 + 0 * DM, false, G == 256 ? (const float*)(ws + WS_PART) : nullptr); } SEAM(10);
#endif

    TSTAMP(11); if (IN(11)) { pg8::Gemm g{(const bf16*)(ws + WS_U), (const bf16*)(ws + WS_WREC), MT, RIW, 2048, 2048, 0}; pg8::StaticOrder S; S.init(MT, RIW, G, bid, 0, 2048);
        pg8::EpiRec E{(bf16*)(ws + WS_PREC), (bf16*)(ws + WS_HG)}; pg8::gemm_phase<pg8::EpiRec, pg8::StaticOrder, true, true>(lds, g, S, E); } SEAM(11);
#if (DUPMASK >> 11) & 1
    TSTAMP(11); if (IN(11)) { pg8::Gemm g{(const bf16*)(ws + WS_U), (const bf16*)(ws + WS_WREC), MT, RIW, 2048, 2048, 0}; pg8::StaticOrder S; S.init(MT, RIW, G, bid, 0, 2048);
        pg8::EpiRec E{(bf16*)(ws + WS_PREC), (bf16*)(ws + WS_HG)}; pg8::gemm_phase<pg8::EpiRec, pg8::StaticOrder, true, true>(lds, g, S, E); } SEAM(11);
#endif

    TSTAMP(12); if (IN(12)) { conv_phase(P); hg_a_phase(P, lds); } SEAM(12);
#if (DUPMASK >> 12) & 1
    TSTAMP(12); if (IN(12)) { conv_phase(P); hg_a_phase(P, lds); } SEAM(12);
#endif

    TSTAMP(13); if (IN(13)) { hg_b_phase(P); } SEAM(13);
#if (DUPMASK >> 13) & 1
    TSTAMP(13); if (IN(13)) { hg_b_phase(P); } SEAM(13);
#endif

    TSTAMP(14); if (IN(14)) { hg_c_phase(P, lds); } SEAM(14);
#if (DUPMASK >> 14) & 1
    TSTAMP(14); if (IN(14)) { hg_c_phase(P, lds); } SEAM(14);
#endif

    TSTAMP(15); if (IN(15)) { pg8::Gemm g{(const bf16*)(ws + WS_XC), (const bf16*)(ws + WS_WLRU), MT, 4096, 128, 1024, 1}; pg8::StaticOrder S; S.init(MT, 4096, G, bid, 0, 128);
        pg8::EpiStore E{(bf16*)(ws + WS_LAB), 4096}; pg8::gemm_phase<pg8::EpiStore, pg8::StaticOrder, false, true>(lds, g, S, E); } SEAM(15);
#if (DUPMASK >> 15) & 1
    TSTAMP(15); if (IN(15)) { pg8::Gemm g{(const bf16*)(ws + WS_XC), (const bf16*)(ws + WS_WLRU), MT, 4096, 128, 1024, 1}; pg8::StaticOrder S; S.init(MT, 4096, G, bid, 0, 128);
        pg8::EpiStore E{(bf16*)(ws + WS_LAB), 4096}; pg8::gemm_phase<pg8::EpiStore, pg8::StaticOrder, false, true>(lds, g, S, E); } SEAM(15);
#endif

    TSTAMP(16); if (IN(16)) { lru_s1_phase(P); xcd_barrier(xbar); lru_prefix_phase(P); } SEAM(16);
#if (DUPMASK >> 16) & 1
    TSTAMP(16); if (IN(16)) { lru_s1_phase(P); xcd_barrier(xbar); lru_prefix_phase(P); } SEAM(16);
#endif

    TSTAMP(17); if (IN(17)) { lru_s2_phase(P, lds); } SEAM(17);
#if (DUPMASK >> 17) & 1
    TSTAMP(17); if (IN(17)) { lru_s2_phase(P, lds); } SEAM(17);
#endif

    TSTAMP(18); if (IN(18)) { pg8::Gemm g{(const bf16*)(ws + WS_MIX), (const bf16*)(ws + WS_WMIX1), MT, 2048, 2048, 2048, 0}; pg8::StaticOrder S; S.init(MT, 2048, G, bid, 1, 2048);
        pg8::EpiResGate E{(float*)(ws + WS_H), mod1 + 2 * DM, nullptr, 2048 / 64, nullptr, nullptr}; pg8::gemm_phase<pg8::EpiResGate, pg8::StaticOrder, true, true>(lds, g, S, E); } SEAM(18);
#if (DUPMASK >> 18) & 1
    TSTAMP(18); if (IN(18)) { pg8::Gemm g{(const bf16*)(ws + WS_MIX), (const bf16*)(ws + WS_WMIX1), MT, 2048, 2048, 2048, 0}; pg8::StaticOrder S; S.init(MT, 2048, G, bid, 1, 2048);
        pg8::EpiResGate E{(float*)(ws + WS_H), mod1 + 2 * DM, nullptr, 2048 / 64, nullptr, nullptr}; pg8::gemm_phase<pg8::EpiResGate, pg8::StaticOrder, true, true>(lds, g, S, E); } SEAM(18);
#endif

    TSTAMP(19); if (IN(19)) { norm_phase<1>(P, P.in[I_NFFN] + DM, mod1 + 3 * DM, true); } SEAM(19);
#if (DUPMASK >> 19) & 1
    TSTAMP(19); if (IN(19)) { norm_phase<1>(P, P.in[I_NFFN] + DM, mod1 + 3 * DM, true); } SEAM(19);
#endif

    TSTAMP(20); if (IN(20)) { pg8::Gemm g{(const bf16*)(ws + WS_U), (const bf16*)(ws + WS_WGU1), MT, 2 * FFH, 2048, 2048, 0}; pg8::StaticOrder S; S.init(MT, 2 * FFH, G, bid, 1, 2048);
        pg8::EpiSwiGLU E{(bf16*)(ws + WS_HID), FFH}; pg8::gemm_phase<pg8::EpiSwiGLU, pg8::StaticOrder, true, true>(lds, g, S, E); } SEAM(20);
#if (DUPMASK >> 20) & 1
    TSTAMP(20); if (IN(20)) { pg8::Gemm g{(const bf16*)(ws + WS_U), (const bf16*)(ws + WS_WGU1), MT, 2 * FFH, 2048, 2048, 0}; pg8::StaticOrder S; S.init(MT, 2 * FFH, G, bid, 1, 2048);
        pg8::EpiSwiGLU E{(bf16*)(ws + WS_HID), FFH}; pg8::gemm_phase<pg8::EpiSwiGLU, pg8::StaticOrder, true, true>(lds, g, S, E); } SEAM(20);
#endif

    TSTAMP(21); if (IN(21)) { pg8::Gemm g{(const bf16*)(ws + WS_HID), (const bf16*)(ws + WS_WD1), MT, 2048, FFH, FFH, 0}; pg8::StaticOrder S; S.init(MT, 2048, G, bid, 1, FFH);
        pg8::EpiResGate E{(float*)(ws + WS_H), mod1 + 5 * DM, nullptr, FFH / 64, nullptr, nullptr}; pg8::gemm_phase<pg8::EpiResGate, pg8::StaticOrder, true, true>(lds, g, S, E); } SEAM(21);
#if (DUPMASK >> 21) & 1
    TSTAMP(21); if (IN(21)) { pg8::Gemm g{(const bf16*)(ws + WS_HID), (const bf16*)(ws + WS_WD1), MT, 2048, FFH, FFH, 0}; pg8::StaticOrder S; S.init(MT, 2048, G, bid, 1, FFH);
        pg8::EpiResGate E{(float*)(ws + WS_H), mod1 + 5 * DM, nullptr, FFH / 64, nullptr, nullptr}; pg8::gemm_phase<pg8::EpiResGate, pg8::StaticOrder, true, true>(lds, g, S, E); } SEAM(21);
#endif

    TSTAMP(22); if (IN(22)) { norm_phase<2>(P, P.in[I_FNW], nullptr, true); }
#undef IN
#undef SEAM
}

extern "C" void kernel_launch(void* const* d_in, const int* in_sizes, int n_in, void* d_out, int out_size, void* d_ws, size_t ws_size, hipStream_t stream) {
    static int grid = 0;
    if (grid == 0) {
        if (n_in != 30 || ws_size < WS_END) { fprintf(stderr, "kernel_launch: n_in %d ws %zu (need 30, >= %zu)\n", n_in, ws_size, (size_t)WS_END); }
        int dev = 0, cus = 0, per_cu = 0;
        hipGetDevice(&dev); hipDeviceGetAttribute(&cus, hipDeviceAttributeMultiprocessorCount, dev);
        if (hipFuncSetAttribute((const void*)mega_fwd, hipFuncAttributeMaxDynamicSharedMemorySize, LDS_BYTES) != hipSuccess) fprintf(stderr, "kernel_launch: hipFuncSetAttribute failed\n");
        if (hipOccupancyMaxActiveBlocksPerMultiprocessor(&per_cu, (const void*)mega_fwd, 512, LDS_BYTES) != hipSuccess || per_cu < 1) { fprintf(stderr, "kernel_launch: occupancy query says %d\n", per_cu); per_cu = 1; }
        (void)hipGetLastError();
        grid = cus * 1;
        if (grid <= 0) grid = 256;
    }
    (void)hipMemsetAsync((char*)d_ws + WS_XBAR, 0, 16384, stream);
    Params p{};
    for (int i = 0; i < 30; ++i) p.in[i] = (const float*)d_in[i];
    p.out = (float*)d_out; p.ws = (unsigned char*)d_ws;
    int lo = 0, hi = NPHASE;
    void* args[] = {(void*)&p, (void*)&lo, (void*)&hi};
    hipError_t e = hipLaunchCooperativeKernel((const void*)mega_fwd, dim3(grid), dim3(512), args, LDS_BYTES, stream);
    if (e != hipSuccess) fprintf(stderr, "kernel_launch: cooperative launch failed: %s (grid %d)\n", hipGetErrorString(e), grid);
}
```

```cpp
#include <hip/hip_runtime.h>
#include <hip/hip_bf16.h>
#include <hip/hip_cooperative_groups.h>
#include <cstdio>
#include <cstdint>
namespace cg = cooperative_groups;
#ifndef TPH_LO
#define TPH_LO -1
#define TPH_HI -1
#endif

constexpr int DM = 2048, NBATCH = 4, SEQL = 4096, CTXL = 256, TPB = SEQL + CTXL, MT = NBATCH * TPB;
constexpr int FFH = 5632, AIW = 2624, AIWP = 2816, RIW = 7168, MODW = 6 * DM;
constexpr float EPS = 1e-6f;
constexpr size_t MiB = 1u << 20;
constexpr size_t WS_MOD = 0;
constexpr size_t WS_COSA = 1 * MiB, WS_SINA = 2 * MiB;
constexpr size_t WS_COSB = 3 * MiB, WS_SINB = 3 * MiB + 512 * 1024;
constexpr size_t WS_LB = 4 * MiB, WS_SP8 = 4 * MiB + 8192;
constexpr size_t WS_CARR = 5 * MiB;
constexpr size_t WS_HGD = 10 * MiB;
constexpr size_t WS_PART = 672 * MiB;
constexpr size_t WS_XBAR = 14 * MiB;
constexpr size_t WS_H = 16 * MiB;
constexpr size_t WS_U = 152 * MiB;
constexpr size_t WS_MIX = 220 * MiB;
constexpr size_t WS_WREC = 288 * MiB, WS_WLRU = 316 * MiB, WS_WMIX1 = 318 * MiB, WS_WGU1 = 326 * MiB, WS_WD1 = 370 * MiB;
constexpr size_t WS_WATT = 392 * MiB, WS_WUQ = 403 * MiB, WS_WUKV = 403 * MiB + 1536 * 512 * 2  , WS_WMIX0 = 407 * MiB, WS_WGU0 = 415 * MiB, WS_WD0 = 459 * MiB;
constexpr size_t WS_F = 482 * MiB;
constexpr size_t WS_PROJ = WS_F;
constexpr size_t WS_QA = 576 * MiB, WS_KA = 610 * MiB, WS_CQN = 619 * MiB, WS_CKVN = 636 * MiB, WS_KR = 653 * MiB, WS_QB = 656 * MiB;
constexpr size_t WS_KVB = WS_U;
constexpr size_t WS_HID = WS_F;
constexpr size_t WS_LAB = 392 * MiB;
constexpr size_t WS_SS = WS_LAB;
constexpr size_t WS_PREC = 528 * MiB;
constexpr size_t WS_HG = 596 * MiB;
constexpr int PRW = 2048;
constexpr size_t WS_XC = WS_U;
constexpr size_t WS_END = 768 * MiB;
constexpr int LDS_BYTES = 147456;

#define LAS __attribute__((address_space(3)))
typedef unsigned short bf16;
typedef unsigned v4u __attribute__((ext_vector_type(4)));
typedef unsigned v2u __attribute__((ext_vector_type(2)));
typedef float f32x4 __attribute__((ext_vector_type(4)));
typedef short bf16x8 __attribute__((ext_vector_type(8)));
typedef __bf16 bf2_t __attribute__((ext_vector_type(2)));
typedef float f2_t __attribute__((ext_vector_type(2)));
__device__ __forceinline__ unsigned cvtpk(float lo, float hi) { f2_t v = {lo, hi}; bf2_t r = __builtin_convertvector(v, bf2_t); return __builtin_bit_cast(unsigned, r); }
__device__ __forceinline__ float bflo(unsigned w) { return __uint_as_float(w << 16); }
__device__ __forceinline__ float bfhi(unsigned w) { return __uint_as_float(w & 0xffff0000u); }
__device__ __forceinline__ float bf2f(bf16 h) { return __uint_as_float((unsigned)h << 16); }
__device__ __forceinline__ bf16 f2bf(float f) { return (bf16)(cvtpk(f, f) & 0xffffu); }
__device__ __forceinline__ float wave_sum(float v) {
#pragma unroll
    for (int o = 1; o < 64; o <<= 1) v += __shfl_xor(v, o);
    return v;
}
__device__ __forceinline__ float sigmoidf_(float x) { return __builtin_amdgcn_rcpf(1.f + __expf(-x)); }
__device__ __forceinline__ float siluf_(float x) { return x * sigmoidf_(x); }
#define LDS_WAIT() asm volatile("s_waitcnt lgkmcnt(0)" ::: "memory")
namespace pg8 {
#define PG8_LAS __attribute__((address_space(3)))
typedef unsigned short bf16_t;
typedef short bf16x8 __attribute__((ext_vector_type(8)));
typedef float f32x4 __attribute__((ext_vector_type(4)));
typedef unsigned u32x4 __attribute__((ext_vector_type(4)));
constexpr int BM = 256, BK = 64, HALF = 128, HTB = HALF * BK * 2  , STAGE_BYTES = 8 * HTB, NXCD = 8, WGM = 8;

__host__ __device__ __forceinline__ int lds_byte(int r, int c) { const int st = (r >> 4) * 2 + (c >> 5), rr = r & 15, cc = c & 31, ob = rr * 64 + cc * 2; return st * 1024 + (ob ^ (((ob >> 9) & 1) << 5)); }
__host__ __device__ __forceinline__ void stage_rc(int b, int& R, int& C) { const int st = b / 1024, sb = b % 1024, swz = sb ^ (((sb >> 9) & 1) << 5); R = (st >> 1) * 16 + swz / 64; C = (st & 1) * 32 + (swz % 64) / 2; }
__host__ __device__ __forceinline__ int perm32(int rho) { const int n = rho >> 4, i = rho & 15; return 8 * (i >> 2) + 4 * n + (i & 3); }
struct Unit { int pm, pn, k0, nt; };
struct Gemm { const bf16_t* A; const bf16_t* Bt; int M, N, K, lda, grp;
    __device__ __forceinline__ const char* abase(const Unit& u) const { return (const char*)A + (size_t)u.pm * 256 * lda * 2 + (grp == 1 ? (size_t)(u.pn >> 2) * 512 : (grp == 2 && u.pn >= 6) ? (size_t)17408 * 512 * 2 : 0) + (size_t)u.k0 * 128; }
    __device__ __forceinline__ const char* bbase(const Unit& u) const { return (const char*)Bt + (size_t)u.pn * 256 * K * 2 + (size_t)u.k0 * 128; } };
struct StaticOrder {
    int nM, nN, nwg, G, c, skip, ntf, split;
    __device__ void init(int M, int N, int G_, int c_, int skip_, int K_ = 0, int split_ = 0) { ntf = K_ / BK; split = split_; if (split_) skip_ = 1; skip = skip_; nM = skip_ ? 64 : M / BM; nN = N / BM; nwg = nM * nN; G = G_; c = c_; }
    __device__ bool next(int i, Unit& u) const {
        u.k0 = 0; u.nt = ntf;
        if (split && i >= 2) { if (i > 2 || c >= 128) return false; const int uc = c >> 2; u.pm = (uc >> 3) * 17; u.pn = uc & 7; u.nt = ntf >> 2; u.k0 = (c & 3) * u.nt; return true; }
        const long L = (long)i * G + c; if (L >= nwg) return false;
        int wgid = (int)L; { const int q = nwg / NXCD, r = nwg % NXCD, xcd = wgid % NXCD, off = wgid / NXCD; wgid = (xcd < r ? xcd * (q + 1) : r * (q + 1) + (xcd - r) * q) + off; }
        const int nig = WGM * nN, gid = wgid / nig, fm = gid * WGM, gsz = (nM - fm) < WGM ? (nM - fm) : WGM;
        int pm = fm + ((wgid % nig) % gsz); u.pn = (wgid % nig) / gsz;
        if (skip) pm = (pm >> 4) * 17 + 1 + (pm & 15);
        u.pm = pm; return true;
    }
    __device__ __forceinline__ void a_ready(const Unit&) const {}
    __device__ __forceinline__ void done(const Unit&) const {}
};
__device__ __forceinline__ unsigned cvt_pk_bf16(float lo, float hi) { return ::cvtpk(lo, hi); }
__device__ __forceinline__ float sigm(float x) { return __builtin_amdgcn_rcpf(1.f + __expf(-x)); }
struct EpiStore {
    static constexpr bool PERM = true, AFTER_DRAIN = false;
    bf16_t* O; int ldc;
    __device__ __forceinline__ void operator()(const f32x4 (&acc)[2][2][4][2], const Unit& u, int wr, int wc, int fr, int fq) const {
        const int row0 = u.pm * BM + wr * 64 + fr, col0 = u.pn * BM + wc * 32 + 8 * fq;
#pragma unroll
        for (int ai = 0; ai < 2; ++ai)
#pragma unroll
            for (int m = 0; m < 4; ++m) { bf16_t* rowp = O + (size_t)(row0 + ai * HALF + m * 16) * ldc + col0;
#pragma unroll
                for (int bj = 0; bj < 2; ++bj) { const f32x4 v0 = acc[ai][bj][m][0], v1 = acc[ai][bj][m][1];
                    u32x4 w; w.x = cvt_pk_bf16(v0[0], v0[1]); w.y = cvt_pk_bf16(v0[2], v0[3]); w.z = cvt_pk_bf16(v1[0], v1[1]); w.w = cvt_pk_bf16(v1[2], v1[3]);
                    *(u32x4*)(rowp + bj * HALF) = w; } }
    }
};
struct EpiMla {
    static constexpr bool PERM = true, AFTER_DRAIN = false;
    bf16_t* QB; bf16_t* KVB;
    __device__ __forceinline__ void operator()(const f32x4 (&acc)[2][2][4][2], const Unit& u, int wr, int wc, int fr, int fq) const {
        const bool kv = u.pn >= 6; const int ldc = kv ? 2048 : 1536;
        bf16_t* O = kv ? KVB : QB;
        const int row0 = u.pm * BM + wr * 64 + fr, col0 = (kv ? u.pn - 6 : u.pn) * BM + wc * 32 + 8 * fq;
#pragma unroll
        for (int ai = 0; ai < 2; ++ai)
#pragma unroll
            for (int m = 0; m < 4; ++m) { bf16_t* rowp = O + (size_t)(row0 + ai * HALF + m * 16) * ldc + col0;
#pragma unroll
                for (int bj = 0; bj < 2; ++bj) { const f32x4 v0 = acc[ai][bj][m][0], v1 = acc[ai][bj][m][1];
                    u32x4 w; w.x = cvt_pk_bf16(v0[0], v0[1]); w.y = cvt_pk_bf16(v0[2], v0[3]); w.z = cvt_pk_bf16(v1[0], v1[1]); w.w = cvt_pk_bf16(v1[2], v1[3]);
                    *(u32x4*)(rowp + bj * HALF) = w; } }
    }
};
struct EpiRec {
    static constexpr bool PERM = true, AFTER_DRAIN = false;
    bf16_t* P2; bf16_t* HG;
    __device__ __forceinline__ void operator()(const f32x4 (&acc)[2][2][4][2], const Unit& u, int wr, int wc, int fr, int fq) const {
        const int row0 = u.pm * BM + wr * 64 + fr, b = u.pm / 17, t0 = (u.pm % 17) * BM + wr * 64 + fr;
#pragma unroll
        for (int bj = 0; bj < 2; ++bj) {
            bf16_t* base; size_t rstride;
            if (u.pn < 8) { base = P2 + (size_t)row0 * 2048 + u.pn * BM + bj * HALF + wc * 32 + 8 * fq; rstride = 2048; }
            else { const int sec = (u.pn - 8) >> 2, head = ((u.pn - 8) & 3) * 2 + bj;
                base = HG + ((((size_t)sec * 4 + b) * 8 + head) * 4352 + t0) * 128 + wc * 32 + 8 * fq; rstride = 128; }
#pragma unroll
            for (int ai = 0; ai < 2; ++ai)
#pragma unroll
                for (int m = 0; m < 4; ++m) { const f32x4 v0 = acc[ai][bj][m][0], v1 = acc[ai][bj][m][1];
                    u32x4 w; w.x = cvt_pk_bf16(v0[0], v0[1]); w.y = cvt_pk_bf16(v0[2], v0[3]); w.z = cvt_pk_bf16(v1[0], v1[1]); w.w = cvt_pk_bf16(v1[2], v1[3]);
                    *(u32x4*)(base + (size_t)(ai * HALF + m * 16) * rstride) = w; }
        }
    }
};
struct EpiSwiGLU {
    static constexpr bool PERM = true, AFTER_DRAIN = false;
    bf16_t* O; int ldc;
    __device__ __forceinline__ void operator()(const f32x4 (&acc)[2][2][4][2], const Unit& u, int wr, int wc, int fr, int fq) const {
        const int row0 = u.pm * BM + wr * 64 + fr, col0 = u.pn * HALF + wc * 32 + 8 * fq;
#pragma unroll
        for (int ai = 0; ai < 2; ++ai)
#pragma unroll
            for (int m = 0; m < 4; ++m) { bf16_t* rowp = O + (size_t)(row0 + ai * HALF + m * 16) * ldc + col0;
                float r[8];
#pragma unroll
                for (int n = 0; n < 2; ++n)
#pragma unroll
                    for (int e = 0; e < 4; ++e) { const float g = acc[ai][0][m][n][e], up = acc[ai][1][m][n][e]; r[n * 4 + e] = g * sigm(g) * up; }
                u32x4 w; w.x = cvt_pk_bf16(r[0], r[1]); w.y = cvt_pk_bf16(r[2], r[3]); w.z = cvt_pk_bf16(r[4], r[5]); w.w = cvt_pk_bf16(r[6], r[7]);
                *(u32x4*)rowp = w; }
    }
};
struct EpiResGate {
    static constexpr bool PERM = false, AFTER_DRAIN = false;
    float* H; const float* gate; float* part; int ntf; const float* xin; const float* cin;
    __device__ __forceinline__ void operator()(const f32x4 (&acc)[2][2][4][2], const Unit& u, int wr, int wc, int fr, int fq) const {
        const int cond = (u.pm % 17 == 0) ? 4 : u.pm / 17;
        const float* gv = gate + (size_t)cond * 12288;
        const int col0 = u.pn * BM + wc * 32 + 4 * fq;
        const bool sl = u.nt != ntf;
        const int row0 = sl ? (u.k0 / u.nt) * 1024 + (u.pm / 17) * BM + wr * 64 + fr : u.pm * BM + wr * 64 + fr;
        float* base = sl ? part : H;
        f32x4 g4[2][2];
#pragma unroll
        for (int bj = 0; bj < 2; ++bj)
#pragma unroll
            for (int n = 0; n < 2; ++n) g4[bj][n] = *(const f32x4*)(gv + col0 + bj * HALF + n * 16);
#pragma unroll
        for (int ai = 0; ai < 2; ++ai)
#pragma unroll
            for (int m = 0; m < 4; ++m) { float* rowp = base + (size_t)(row0 + ai * HALF + m * 16) * 2048 + col0;
                const int rl = wr * 64 + fr + ai * HALF + m * 16, tb_ = u.pm % 17, b_ = u.pm / 17;
                const float* rdp = (xin == nullptr) ? rowp : (tb_ == 0 ? cin + ((size_t)b_ * 256 + rl) * 2048 + col0 : xin + ((size_t)b_ * 4096 + (tb_ - 1) * 256 + rl) * 2048 + col0);
#pragma unroll
                for (int bj = 0; bj < 2; ++bj)
#pragma unroll
                    for (int n = 0; n < 2; ++n) { f32x4* p = (f32x4*)(rowp + bj * HALF + n * 16); const f32x4 ga = g4[bj][n] * acc[ai][bj][m][n]; if (sl) *p = ga; else *p = *(const f32x4*)(rdp + bj * HALF + n * 16) + ga; }
                asm volatile("" ::: "memory"); }
    }
};
template <class Epi, class Sched, bool ALIGN_EPI = false, bool SP2 = false>
__device__ __forceinline__ void gemm_phase(PG8_LAS unsigned char* lds, const Gemm g, const Sched& S, const Epi& E) {
    const int tid = threadIdx.x, wid = __builtin_amdgcn_readfirstlane(tid >> 6), lane = tid & 63, wr = wid >> 2, wc = wid & 3, fr = lane & 15, fq = lane >> 4;
    const int K = g.K; int nt = K / BK;
    unsigned voffA[2], voffB[2];
#pragma unroll
    for (int i = 0; i < 2; ++i) { int R, C; stage_rc(tid * 16 + i * 8192, R, C); const int Rb = Epi::PERM ? ((R & ~31) + perm32(R & 31)) : R;
        voffA[i] = (unsigned)(R * g.lda + C) * 2u; voffB[i] = (unsigned)(Rb * K + C) * 2u; }
    const size_t kstep = (size_t)(BK * 2);
    const size_t hstep = (size_t)HALF * K * 2; const size_t hstepA = (size_t)HALF * g.lda * 2;
    const size_t tstep = 2 * hstep;
    const unsigned ldsw = (unsigned)wid * 1024u;
    const int aoff = lds_byte(wr * 64 + fr, fq * 8), boff = lds_byte(wc * 32 + fr, fq * 8);
#define PG8_SA(b, h) (((b) * 2 + (h)) * HTB)
#define PG8_SB(b, h) ((4 + (b) * 2 + (h)) * HTB)
#define PG8_STAGE(bufoff, gbase, voff) do { _Pragma("unroll") for (int _i = 0; _i < 2; ++_i) \
        __builtin_amdgcn_global_load_lds((const unsigned*)((const char*)(gbase) + (voff)[_i]), (PG8_LAS unsigned*)(lds + (bufoff) + ldsw + _i * 8192), 16, 0, 0); } while (0)
#define PG8_LDA(dst, b, h) do { _Pragma("unroll") for (int m = 0; m < 4; ++m) _Pragma("unroll") for (int k = 0; k < 2; ++k) dst[m][k] = *(const PG8_LAS bf16x8*)(lds + PG8_SA(b, h) + aoff + m * 2048 + k * 1024); } while (0)
#define PG8_LDB(dst, b, h) do { _Pragma("unroll") for (int n = 0; n < 2; ++n) _Pragma("unroll") for (int k = 0; k < 2; ++k) dst[n][k] = *(const PG8_LAS bf16x8*)(lds + PG8_SB(b, h) + boff + n * 2048 + k * 1024); } while (0)
#define PG8_MMA(ai, bj, At, Bt) do { __builtin_amdgcn_s_setprio(1); _Pragma("unroll") for (int m = 0; m < 4; ++m) _Pragma("unroll") for (int n = 0; n < 2; ++n) _Pragma("unroll") for (int k = 0; k < 2; ++k) \
        acc[ai][bj][m][n] = __builtin_amdgcn_mfma_f32_16x16x32_bf16(Bt[n][k], At[m][k], acc[ai][bj][m][n], 0, 0, 0); __builtin_amdgcn_s_setprio(0); } while (0)
#define PG8_WAIT_V(n) asm volatile("s_waitcnt vmcnt(" #n ")" ::: "memory")
#define PG8_WAIT_L(n) asm volatile("s_waitcnt lgkmcnt(" #n ")" ::: "memory")
#define PG8_BAR __builtin_amdgcn_s_barrier()
#define PG8_SCHED __builtin_amdgcn_sched_barrier(0)
    Unit cur, nxt; int ui = 0;
    if (!S.next(0, cur)) return;
    nt = cur.nt;
    f32x4 acc[2][2][4][2];
#pragma unroll
    for (int a = 0; a < 2; ++a)
#pragma unroll
        for (int b = 0; b < 2; ++b)
#pragma unroll
            for (int m = 0; m < 4; ++m)
#pragma unroll
                for (int n = 0; n < 2; ++n) acc[a][b][m][n] = (f32x4){0.f, 0.f, 0.f, 0.f};
    bf16x8 At[4][2], B0[2][2], B1[2][2];
    const char* cA = g.abase(cur); const char* cB = g.bbase(cur);
    S.a_ready(cur);
    if constexpr (SP2) {
        PG8_STAGE(PG8_SB(0, 0), cB, voffB); PG8_STAGE(PG8_SB(0, 1), cB + hstep, voffB); PG8_STAGE(PG8_SA(0, 0), cA, voffA); PG8_STAGE(PG8_SA(0, 1), cA + hstepA, voffA);
        if (wr == 1) PG8_BAR;
        PG8_WAIT_V(2); PG8_BAR;
        PG8_STAGE(PG8_SB(1, 0), cB + kstep, voffB); PG8_STAGE(PG8_SA(1, 0), cA + kstep, voffA); PG8_STAGE(PG8_SB(1, 1), cB + hstep + kstep, voffB);
        PG8_WAIT_V(6); PG8_BAR;
    } else {
        PG8_STAGE(PG8_SB(0, 0), cB, voffB); PG8_STAGE(PG8_SA(0, 0), cA, voffA); PG8_STAGE(PG8_SB(0, 1), cB + hstep, voffB); PG8_STAGE(PG8_SA(0, 1), cA + hstepA, voffA);
        if (wr == 1) PG8_BAR;
        PG8_WAIT_V(4); PG8_BAR;
        PG8_STAGE(PG8_SB(1, 0), cB + kstep, voffB); PG8_STAGE(PG8_SA(1, 0), cA + kstep, voffA); PG8_STAGE(PG8_SB(1, 1), cB + hstep + kstep, voffB);
        PG8_WAIT_V(6); PG8_BAR;
    }
    for (;;) {
        const bool has_next = S.next(ui + 1, nxt);
        const char* nA = has_next ? g.abase(nxt) : cA; const char* nB = has_next ? g.bbase(nxt) : cB;
        for (int t = 0; t < nt; t += 2) {
            const bool last = (t == nt - 2);
            const char* a1 = cA + (size_t)(t + 1) * kstep;
            const char* a2 = last ? nA : cA + (size_t)(t + 2) * kstep; const char* b2 = last ? nB : cB + (size_t)(t + 2) * kstep;
            const char* a3 = a2 + kstep; const char* b3 = b2 + kstep;
            if (last && has_next) S.a_ready(nxt);
            if constexpr (SP2) {
            PG8_LDB(B0, 0, 0); PG8_LDB(B1, 0, 1); PG8_SCHED; PG8_LDA(At, 0, 0); PG8_STAGE(PG8_SA(1, 1), a1 + hstepA, voffA);
            PG8_WAIT_V(8); PG8_WAIT_L(0); PG8_BAR; PG8_MMA(0, 0, At, B0); PG8_MMA(0, 1, At, B1); PG8_BAR; PG8_SCHED;
            PG8_LDA(At, 0, 1); PG8_STAGE(PG8_SB(0, 0), b2, voffB); PG8_STAGE(PG8_SB(0, 1), b2 + hstep, voffB); PG8_STAGE(PG8_SA(0, 0), a2, voffA);
            PG8_WAIT_V(8); PG8_WAIT_L(0); PG8_BAR; PG8_MMA(1, 0, At, B0); PG8_MMA(1, 1, At, B1); PG8_BAR; PG8_SCHED;
            PG8_LDB(B0, 1, 0); PG8_LDB(B1, 1, 1); PG8_SCHED; PG8_LDA(At, 1, 0); PG8_STAGE(PG8_SA(0, 1), a2 + hstepA, voffA);
            PG8_WAIT_V(8); PG8_WAIT_L(0); PG8_BAR; PG8_MMA(0, 0, At, B0); PG8_MMA(0, 1, At, B1); PG8_BAR; PG8_SCHED;
            PG8_LDA(At, 1, 1); PG8_STAGE(PG8_SB(1, 0), b3, voffB); PG8_STAGE(PG8_SB(1, 1), b3 + hstep, voffB); PG8_STAGE(PG8_SA(1, 0), a3, voffA);
            PG8_WAIT_V(8); PG8_WAIT_L(0); PG8_BAR; PG8_MMA(1, 0, At, B0); PG8_MMA(1, 1, At, B1); PG8_BAR; PG8_SCHED;
            } else {
            PG8_LDB(B0, 0, 0); PG8_SCHED; PG8_LDA(At, 0, 0); PG8_STAGE(PG8_SA(1, 1), a1 + hstepA, voffA);
            PG8_WAIT_L(8); PG8_BAR; PG8_WAIT_L(0); PG8_MMA(0, 0, At, B0); PG8_BAR; PG8_SCHED;
            PG8_LDB(B1, 0, 1); PG8_STAGE(PG8_SB(0, 0), b2, voffB);
            PG8_BAR; PG8_WAIT_L(0); PG8_MMA(0, 1, At, B1); PG8_BAR;
            PG8_LDA(At, 0, 1); PG8_STAGE(PG8_SA(0, 0), a2, voffA);
            PG8_BAR; PG8_WAIT_L(0); PG8_MMA(1, 0, At, B0); PG8_BAR; PG8_SCHED;
            PG8_STAGE(PG8_SB(0, 1), b2 + hstep, voffB);
            PG8_WAIT_V(6); PG8_BAR; PG8_MMA(1, 1, At, B1); PG8_BAR;
            PG8_LDB(B0, 1, 0); PG8_SCHED; PG8_LDA(At, 1, 0); PG8_STAGE(PG8_SA(0, 1), a2 + hstepA, voffA);
            PG8_WAIT_L(8); PG8_BAR; PG8_WAIT_L(0); PG8_MMA(0, 0, At, B0); PG8_BAR; PG8_SCHED;
            PG8_LDB(B1, 1, 1); PG8_STAGE(PG8_SB(1, 0), b3, voffB);
            PG8_BAR; PG8_WAIT_L(0); PG8_MMA(0, 1, At, B1); PG8_BAR;
            PG8_LDA(At, 1, 1); PG8_STAGE(PG8_SA(1, 0), a3, voffA);
            PG8_BAR; PG8_WAIT_L(0); PG8_MMA(1, 0, At, B0); PG8_BAR; PG8_SCHED;
            PG8_STAGE(PG8_SB(1, 1), b3 + hstep, voffB);
            PG8_WAIT_V(6); PG8_BAR; PG8_MMA(1, 1, At, B1); PG8_BAR;
            }
        }
        if constexpr (ALIGN_EPI) { if (wr == 0) PG8_BAR; }
        if constexpr (!Epi::AFTER_DRAIN) { E(acc, cur, wr, wc, fr, fq); S.done(cur); }
        if (!has_next) break;
#pragma unroll
        for (int a = 0; a < 2; ++a)
#pragma unroll
            for (int b = 0; b < 2; ++b)
#pragma unroll
                for (int m = 0; m < 4; ++m)
#pragma unroll
                    for (int n = 0; n < 2; ++n) acc[a][b][m][n] = (f32x4){0.f, 0.f, 0.f, 0.f};
        cur = nxt; cA = nA; cB = nB; ++ui; nt = cur.nt;
        if constexpr (ALIGN_EPI) { if (wr == 1) PG8_BAR; }
    }
    PG8_WAIT_V(0);
    if constexpr (!ALIGN_EPI) { if (wr == 0) PG8_BAR; }
    PG8_BAR;
    if constexpr (Epi::AFTER_DRAIN) { E.fused(acc, cur, wr, wc, fr, fq, lds, wid, lane); S.done(cur); }
#undef PG8_SA
#undef PG8_SB
#undef PG8_STAGE
#undef PG8_LDA
#undef PG8_LDB
#undef PG8_MMA
#undef PG8_WAIT_V
#undef PG8_WAIT_L
#undef PG8_BAR
#undef PG8_SCHED
}
}
namespace attn {
using bf16x8 = __attribute__((ext_vector_type(8))) short;
using s16x4  = __attribute__((ext_vector_type(4))) short;
using f32x16 = __attribute__((ext_vector_type(16))) float;
using u32x4  = __attribute__((ext_vector_type(4))) unsigned;
constexpr int NW = 8, QBLK = 32, KVBLK = 64;
constexpr float THR = 8.f;
constexpr size_t SHM_V = KVBLK * 128 * 2;
#define SBAR() __builtin_amdgcn_sched_barrier(0)
__device__ __forceinline__ int crow(int r, int hi) { return (r & 3) + 8 * (r >> 2) + 4 * hi; }
__device__ __forceinline__ void partialSM(f32x16& p0, f32x16& p1, float& m_reg, float& mn, float& alpha, const float C, const float THRS) {
  float pmax = p0[0];
#pragma unroll
  for (int r = 1; r < 16; ++r) pmax = fmaxf(pmax, p0[r]);
#pragma unroll
  for (int r = 0; r < 16; ++r) pmax = fmaxf(pmax, p1[r]);
  { auto rr = __builtin_amdgcn_permlane32_swap(__float_as_uint(pmax), __float_as_uint(pmax), false, false);
    pmax = fmaxf(__uint_as_float(rr[0]), __uint_as_float(rr[1])); }
  if (__builtin_expect(__all(pmax - m_reg <= THRS), 1)) { mn = m_reg; alpha = 1.f; }
  else { mn = fmaxf(m_reg, pmax); alpha = __builtin_amdgcn_exp2f((m_reg - mn) * C); m_reg = mn; }
  float mnC = -mn * C;
#pragma unroll
  for (int r = 0; r < 16; ++r) p0[r] = fmaf(p0[r], C, mnC);
#pragma unroll
  for (int r = 0; r < 16; ++r) p1[r] = fmaf(p1[r], C, mnC);
#pragma unroll
  for (int r = 0; r < 16; ++r) p0[r] = __builtin_amdgcn_exp2f(p0[r]);
}
__device__ __forceinline__ void finishSM(f32x16& p0, f32x16& p1, float alpha, float& l_reg, bf16x8& pa0, bf16x8& pa1, bf16x8& pa2, bf16x8& pa3) {
#pragma unroll
  for (int r = 0; r < 16; ++r) p1[r] = __builtin_amdgcn_exp2f(p1[r]);
  float ps = 0;
#pragma unroll
  for (int r = 0; r < 16; ++r) ps += p0[r];
#pragma unroll
  for (int r = 0; r < 16; ++r) ps += p1[r];
  { auto rr = __builtin_amdgcn_permlane32_swap(__float_as_uint(ps), __float_as_uint(ps), false, false);
    ps = __uint_as_float(rr[0]) + __uint_as_float(rr[1]); }
  l_reg = l_reg * alpha + ps;
#define PK4(P, BASE, OUT) do { unsigned a0 = cvtpk(P[BASE + 0], P[BASE + 1]), a1 = cvtpk(P[BASE + 2], P[BASE + 3]);   \
    unsigned b0 = cvtpk(P[BASE + 4], P[BASE + 5]), b1 = cvtpk(P[BASE + 6], P[BASE + 7]);                              \
    auto r0 = __builtin_amdgcn_permlane32_swap(a0, b0, false, false); auto r1 = __builtin_amdgcn_permlane32_swap(a1, b1, false, false); \
    u32x4 w = {r0[0], r1[0], r0[1], r1[1]}; OUT = *reinterpret_cast<bf16x8*>(&w); } while (0)
  PK4(p0, 0, pa0); PK4(p0, 8, pa1); PK4(p1, 0, pa2); PK4(p1, 8, pa3);
#undef PK4
}
template <int DQK> __device__ __forceinline__ int kswz(int row, int colB) { return row * (DQK * 2) + (colB ^ ((row & 7) << 4)); }
template <int DQK>
__device__ __forceinline__ void qkt(f32x16& p0, f32x16& p1, const char* Ks, const bf16x8* qr, int r32, int hi) {
  p0 = f32x16{}; p1 = f32x16{};
#pragma unroll
  for (int d0 = 0; d0 < DQK / 16; ++d0) { int cb = (d0 * 16 + hi * 8) * 2;
    bf16x8 b0 = *reinterpret_cast<const bf16x8*>(Ks + kswz<DQK>(r32, cb));
    bf16x8 b1 = *reinterpret_cast<const bf16x8*>(Ks + kswz<DQK>(32 + r32, cb));
    p0 = __builtin_amdgcn_mfma_f32_32x32x16_bf16(b0, qr[d0], p0, 0, 0, 0);
    p1 = __builtin_amdgcn_mfma_f32_32x32x16_bf16(b1, qr[d0], p1, 0, 0, 0); }
}
__device__ __forceinline__ int v_st(int k, int c) { const int kk = (k & ~0xC) | ((k & 4) << 1) | ((k & 8) >> 1); return ((kk >> 3) * 4 + (c >> 5)) * 512 + ((kk & 7) * 32 + (c & 31)) * 2; }
__device__ __forceinline__ int v_rd_base(int lane) { return ((lane & 3) << 3) | (((lane >> 2) & 3) << 6) | (((lane >> 4) & 1) << 5) | (((lane >> 5) & 1) << 8); }
constexpr int v_rd_off(int d0, int ks, int half) { return d0 * 512 + ks * 4096 + half * 2048; }
template <int OFF> __device__ __forceinline__ s16x4 tr_read(int vb) {
  s16x4 r; asm volatile("ds_read_b64_tr_b16 %0, %1 offset:%2" : "=&v"(r) : "v"(vb), "i"(OFF) : "memory"); return r;
}
template <int D0> __device__ __forceinline__ void pv_one(f32x16& od, int vb, bf16x8 pa0, bf16x8 pa1, bf16x8 pa2, bf16x8 pa3) {
  const s16x4 l0 = tr_read<v_rd_off(D0, 0, 0)>(vb), h0 = tr_read<v_rd_off(D0, 0, 1)>(vb), l1 = tr_read<v_rd_off(D0, 1, 0)>(vb), h1 = tr_read<v_rd_off(D0, 1, 1)>(vb);
  const s16x4 l2 = tr_read<v_rd_off(D0, 2, 0)>(vb), h2 = tr_read<v_rd_off(D0, 2, 1)>(vb), l3 = tr_read<v_rd_off(D0, 3, 0)>(vb), h3 = tr_read<v_rd_off(D0, 3, 1)>(vb);
  asm volatile("s_waitcnt lgkmcnt(0)" ::: "memory"); SBAR();
#define PK(L, H) (bf16x8){L[0], L[1], L[2], L[3], H[0], H[1], H[2], H[3]}
  od = __builtin_amdgcn_mfma_f32_32x32x16_bf16(pa0, PK(l0, h0), od, 0, 0, 0);
  od = __builtin_amdgcn_mfma_f32_32x32x16_bf16(pa1, PK(l1, h1), od, 0, 0, 0);
  od = __builtin_amdgcn_mfma_f32_32x32x16_bf16(pa2, PK(l2, h2), od, 0, 0, 0);
  od = __builtin_amdgcn_mfma_f32_32x32x16_bf16(pa3, PK(l3, h3), od, 0, 0, 0);
#undef PK
}
__device__ __forceinline__ void pv_d0(f32x16* o, int vb, bf16x8 pa0, bf16x8 pa1, bf16x8 pa2, bf16x8 pa3) {
  pv_one<0>(o[0], vb, pa0, pa1, pa2, pa3); pv_one<1>(o[1], vb, pa0, pa1, pa2, pa3); pv_one<2>(o[2], vb, pa0, pa1, pa2, pa3); pv_one<3>(o[3], vb, pa0, pa1, pa2, pa3);
}
__device__ __forceinline__ void rope8(bf16x8& a, bf16x8& b, const float* cs, const float* sn) {
  const f32x4 c0 = *(const f32x4*)cs, c1 = *(const f32x4*)(cs + 4), s0 = *(const f32x4*)sn, s1 = *(const f32x4*)(sn + 4);
  float x1[8], x2[8], y1[8], y2[8];
#pragma unroll
  for (int e = 0; e < 8; ++e) { x1[e] = __uint_as_float(((unsigned)(unsigned short)a[e]) << 16); x2[e] = __uint_as_float(((unsigned)(unsigned short)b[e]) << 16); }
#pragma unroll
  for (int e = 0; e < 8; ++e) { const float c = e < 4 ? c0[e & 3] : c1[e & 3], s = e < 4 ? s0[e & 3] : s1[e & 3]; y1[e] = x1[e] * c - x2[e] * s; y2[e] = x2[e] * c + x1[e] * s; }
  u32x4 wa = {cvtpk(y1[0], y1[1]), cvtpk(y1[2], y1[3]), cvtpk(y1[4], y1[5]), cvtpk(y1[6], y1[7])};
  u32x4 wb = {cvtpk(y2[0], y2[1]), cvtpk(y2[2], y2[3]), cvtpk(y2[4], y2[5]), cvtpk(y2[6], y2[7])};
  a = *reinterpret_cast<bf16x8*>(&wa); b = *reinterpret_cast<bf16x8*>(&wb);
}
template <int DQK, int LDQ, int LDK, int LDV>
__device__ __forceinline__ void attn_body(const bf16* __restrict__ Qb, const bf16* __restrict__ Kh, const bf16* __restrict__ Kr, const bf16* __restrict__ Vh,
                                          bf16* __restrict__ Ob, int seq, char* lds, const float C, const float THRS, const float* cosq, const float* sinq) {
  constexpr int ND = DQK / 16; constexpr size_t SHM_K = KVBLK * DQK * 2; constexpr int LDO = 2048; constexpr bool X = (DQK == 192);
  const int tid = threadIdx.x, wid = tid >> 6, lane = tid & 63, r32 = lane & 31, hi = lane >> 5;
  char* V_lds = lds; char* K_lds = lds + 2 * SHM_V;
  float* ws = (float*)(lds + 2 * SHM_V + 2 * SHM_K) + wid * 64; float* li_l = ws; float* al_l = ws + 32;
  float m_reg = -1e30f, l_reg = 0; f32x16 o[4] = {}; bf16x8 qr[ND];
  const bf16* Qw = Qb + (long)(wid * QBLK + r32) * LDQ + hi * 8;
#pragma unroll
  for (int d0 = 0; d0 < ND; ++d0) qr[d0] = *reinterpret_cast<const bf16x8*>(Qw + d0 * 16);
  if constexpr (X) { if (cosq) { const float* cs = cosq + (wid * QBLK + r32) * 32 + hi * 8; const float* sn = sinq + (wid * QBLK + r32) * 32 + hi * 8;
      rope8(qr[8], qr[10], cs, sn); rope8(qr[9], qr[11], cs + 16, sn + 16); } }
  const int sr = tid >> 4, sc = (tid & 15) * 8, vst0 = v_st(sr, sc), vst1 = v_st(32 + sr, sc);
  const int xr = tid >> 3, xc = (tid & 7) * 8;
  const int vb0 = (int)(uintptr_t)V_lds + v_rd_base(lane);
  bf16x8 s_vs0, s_vs1, s_ks0, s_ks1, s_kx;
#define SLOAD(k0) do { s_vs0 = *(const bf16x8*)(&Vh[(long)((k0) + sr) * LDV + sc]); s_vs1 = *(const bf16x8*)(&Vh[(long)((k0) + 32 + sr) * LDV + sc]); \
    s_ks0 = *(const bf16x8*)(&Kh[(long)((k0) + sr) * LDK + sc]); s_ks1 = *(const bf16x8*)(&Kh[(long)((k0) + 32 + sr) * LDK + sc]); \
    if constexpr (X) s_kx = *(const bf16x8*)(&Kr[(long)((k0) + xr) * 64 + xc]); } while (0)
#define SWRITE(b) do { *(bf16x8*)(V_lds + (b) * SHM_V + vst0) = s_vs0;          \
    *(bf16x8*)(V_lds + (b) * SHM_V + vst1) = s_vs1; int kc = sc * 2;               \
    *(bf16x8*)(K_lds + (b) * SHM_K + kswz<DQK>(sr, kc)) = s_ks0;                       \
    *(bf16x8*)(K_lds + (b) * SHM_K + kswz<DQK>(32 + sr, kc)) = s_ks1; \
    if constexpr (X) *(bf16x8*)(K_lds + (b) * SHM_K + kswz<DQK>(xr, 256 + xc * 2)) = s_kx; } while (0)
#define RESC(a) do { if (__any((a) < 1.f)) { if (hi == 0) al_l[r32] = (a); asm volatile("s_waitcnt lgkmcnt(0)" ::: "memory"); \
    _Pragma("unroll") for (int d = 0; d < 4; ++d) _Pragma("unroll") for (int r = 0; r < 16; ++r) o[d][r] *= al_l[crow(r, hi)]; } } while (0)
#define TILE(b) do { f32x16 p0, p1; float mn, al; bf16x8 pa0, pa1, pa2, pa3; \
    qkt<DQK>(p0, p1, K_lds + (b) * SHM_K, qr, r32, hi); partialSM(p0, p1, m_reg, mn, al, C, THRS); RESC(al); \
    finishSM(p0, p1, al, l_reg, pa0, pa1, pa2, pa3); SBAR(); pv_d0(o, vb0 + (b) * (int)SHM_V, pa0, pa1, pa2, pa3); } while (0)
  const int NT = seq / KVBLK;
  SLOAD(0); asm volatile("s_waitcnt vmcnt(0)" ::: "memory"); SWRITE(0); SLOAD(KVBLK); __syncthreads();
  for (int j = 0; j < NT; j += 2) {
    SWRITE(1); if (j + 2 < NT) SLOAD((j + 2) * KVBLK);
    TILE(0);
    __syncthreads();
    if (j + 2 < NT) { SWRITE(0); if (j + 3 < NT) SLOAD((j + 3) * KVBLK); }
    TILE(1);
    __syncthreads();
  }
  if (hi == 0) li_l[r32] = l_reg; asm volatile("s_waitcnt lgkmcnt(0)" ::: "memory");
  float rli[16];
#pragma unroll
  for (int r = 0; r < 16; ++r) rli[r] = __builtin_amdgcn_rcpf(li_l[crow(r, hi)]);
  bf16* Ow = Ob + (long)(wid * QBLK) * LDO;
#pragma unroll
  for (int r = 0; r < 16; ++r) { int orow = crow(r, hi);
#pragma unroll
    for (int d0 = 0; d0 < 4; ++d0) Ow[(long)orow * LDO + d0 * 32 + r32] = f2bf(o[d0][r] * rli[r]); }
#undef SLOAD
#undef SWRITE
#undef TILE
#undef RESC
}
}
struct Params { const float* in[30]; float* out; unsigned char* ws; };
enum { I_X = 0, I_C, I_CTX, I_CCTX, I_MODW, I_MODB, I_NMIX, I_NFFN, I_WMIX, I_WG, I_WU, I_WD, I_WATT, I_QNW, I_KNW, I_MQNW, I_WUQ, I_MKVNW, I_WUKV, I_WREC,
       I_CONVW, I_CONVB, I_RAW, I_RAB, I_IXW, I_IXB, I_LAM, I_LBL, I_HGNW, I_FNW };

__device__ __forceinline__ void tr_item(const float* W, int N, bf16* WT, int ldt, int koff, int drow0, LAS float* scr, int k0, int n0, int lane) {
#pragma unroll
    for (int i = 0; i < 32; ++i) { const int kk = 2 * i + (lane >> 5); scr[kk * 33 + (lane & 31)] = W[(size_t)(k0 + kk) * N + n0 + (lane & 31)]; }
    LDS_WAIT();
    const int c = lane & 7;
#pragma unroll
    for (int j = 0; j < 4; ++j) { const int n = (lane >> 3) + 8 * j; const LAS float* s = scr + (8 * c) * 33 + n;
        v4u o; o.x = cvtpk(s[0 * 33], s[1 * 33]); o.y = cvtpk(s[2 * 33], s[3 * 33]); o.z = cvtpk(s[4 * 33], s[5 * 33]); o.w = cvtpk(s[6 * 33], s[7 * 33]);
        *(v4u*)(WT + (size_t)(drow0 + n) * ldt + koff + k0 + 8 * c) = o; }
    LDS_WAIT();
}
template <int MODE>
__device__ __forceinline__ void tr_job(const float* W, int K, int N, bf16* WT, int row_off, int& base, int gw, int NGW, LAS float* scr, int lane) {
    const int nblk = N / 32, nit = (K / 64) * nblk;
    int it = (gw - base % NGW + NGW) % NGW;
    for (; it < nit; it += NGW) { const int kb = it / nblk, n0 = (it % nblk) * 32;
        const int drow0 = MODE ? (n0 >> 7) * 256 + row_off + (n0 & 127) : row_off + n0;
        tr_item(W, N, WT, K, 0, drow0, scr, kb * 64, n0, lane); }
    base += nit;
}
struct TrItem { const float* src; bf16* dst; int N, ldt; };
constexpr int TR_TOTAL = 2624 + 384 + 512 + 2048 + 2048 + 4 * 5632 + 2 * 5632 + 7168 + 256;
__device__ __forceinline__ void tr_decode(const Params& P, int g, TrItem& t) {
    unsigned char* ws = P.ws;
    const float* W; bf16* WT; int K, N, row_off = 0, mode = 0, it = g;
    if (it < 2624) { W = P.in[I_WATT]; WT = (bf16*)(ws + WS_WATT); K = 2048; N = AIW; }
    else if ((it -= 2624) < 384) { W = P.in[I_WUQ]; WT = (bf16*)(ws + WS_WUQ); K = 512; N = 1536; }
    else if ((it -= 384) < 512) { W = P.in[I_WUKV]; WT = (bf16*)(ws + WS_WUKV); K = 512; N = 2048; }
    else if ((it -= 512) < 2048) { W = P.in[I_WMIX]; WT = (bf16*)(ws + WS_WMIX0); K = 2048; N = 2048; }
    else if ((it -= 2048) < 2048) { W = P.in[I_WMIX] + (size_t)2048 * 2048; WT = (bf16*)(ws + WS_WMIX1); K = 2048; N = 2048; }
    else if ((it -= 2048) < 5632) { W = P.in[I_WG]; WT = (bf16*)(ws + WS_WGU0); K = 2048; N = FFH; mode = 1; }
    else if ((it -= 5632) < 5632) { W = P.in[I_WU]; WT = (bf16*)(ws + WS_WGU0); K = 2048; N = FFH; mode = 1; row_off = 128; }
    else if ((it -= 5632) < 5632) { W = P.in[I_WG] + (size_t)2048 * FFH; WT = (bf16*)(ws + WS_WGU1); K = 2048; N = FFH; mode = 1; }
    else if ((it -= 5632) < 5632) { W = P.in[I_WU] + (size_t)2048 * FFH; WT = (bf16*)(ws + WS_WGU1); K = 2048; N = FFH; mode = 1; row_off = 128; }
    else if ((it -= 5632) < 5632) { W = P.in[I_WD]; WT = (bf16*)(ws + WS_WD0); K = FFH; N = 2048; }
    else if ((it -= 5632) < 5632) { W = P.in[I_WD] + (size_t)FFH * 2048; WT = (bf16*)(ws + WS_WD1); K = FFH; N = 2048; }
    else if ((it -= 5632) < 7168) { W = P.in[I_WREC]; WT = (bf16*)(ws + WS_WREC); K = 2048; N = RIW; }
    else { it -= 7168;
        const int which = it >> 7, rem = it & 127, d = rem >> 6, n = (rem >> 3) & 7, sub = rem & 7, kb = sub >> 2, nbk = sub & 3, pn = (n >> 1) * 4 + (n & 1) * 2 + d;
        t.src = (which ? P.in[I_IXW] : P.in[I_RAW]) + (size_t)(d * 8 + n) * 128 * 128 + (size_t)(kb * 64) * 128 + nbk * 32; t.N = 128; t.ldt = 256;
        t.dst = (bf16*)(ws + WS_WLRU) + (size_t)(pn * 256 + which * 128 + nbk * 32) * 256 + (n & 1) * 128 + kb * 64; return; }
    const int nblk = N / 32, kb = it / nblk, n0 = (it - kb * nblk) * 32, k0 = kb * 64;
    const int drow0 = mode ? (n0 >> 7) * 256 + row_off + (n0 & 127) : n0;
    t.src = W + (size_t)k0 * N + n0; t.N = N; t.ldt = K; t.dst = WT + (size_t)drow0 * K + k0;
}
__device__ __forceinline__ void sincos_(float x, float& s, float& c) {
    const float k = rintf(x * 0.15915494309189535f); float r = fmaf(-k, 6.2831854820251465f, x); r = fmaf(-k, -1.7484555e-7f, r);
    s = __sinf(r); c = __cosf(r);
}
__device__ __forceinline__ void phase0(const Params& P, LAS unsigned char* lds) {
    const int tid = threadIdx.x, lane = tid & 63, wave = tid >> 6, G = gridDim.x, bid = blockIdx.x;
    unsigned char* ws = P.ws;
    {
        LAS float* sv = (LAS float*)lds;
        LAS float* red = (LAS float*)(lds + 40960);
        for (int i = tid; i < 5 * 2048; i += 512) { const int j = i >> 11, k = i & 2047; const float v = j < 4 ? P.in[I_C][j * 2048 + k] : P.in[I_CCTX][k]; sv[i] = siluf_(v); }
        __syncthreads();
        float* mod = (float*)(ws + WS_MOD);
        for (int task = bid; task < 192; task += G) {
            const int l = task / 96, n0 = (task % 96) * 128, tc = tid & 31, kg = tid >> 5;
            const float* Wp = P.in[I_MODW] + (size_t)l * 2048 * MODW + n0 + tc * 4;
            f32x4 acc[5];
#pragma unroll
            for (int j = 0; j < 5; ++j) acc[j] = (f32x4){0.f, 0.f, 0.f, 0.f};
#pragma unroll 16
            for (int k = kg; k < 2048; k += 16) { const f32x4 w = *(const f32x4*)(Wp + (size_t)k * MODW);
#pragma unroll
                for (int j = 0; j < 5; ++j) acc[j] += w * sv[j * 2048 + k]; }
#pragma unroll
            for (int j = 0; j < 5; ++j)
#pragma unroll
                for (int e = 0; e < 4; ++e) red[(kg * 32 + tc) * 20 + j * 4 + e] = acc[j][e];
            __syncthreads();
            for (int o = tid; o < 640; o += 512) { const int j = o >> 7, c = o & 127; float s = 0.f;
#pragma unroll
                for (int g = 0; g < 16; ++g) s += red[(g * 32 + (c >> 2)) * 20 + j * 4 + (c & 3)];
                mod[((size_t)l * 5 + j) * MODW + n0 + c] = s + P.in[I_MODB][l * MODW + n0 + c]; }
            __syncthreads();
        }
    }
    {
        const int gid = bid * 512 + tid, GT = G * 512;
        float* cosA = (float*)(ws + WS_COSA); float* sinA = (float*)(ws + WS_SINA); float* cosB = (float*)(ws + WS_COSB); float* sinB = (float*)(ws + WS_SINB);
        for (int i = gid; i < 4096 * 64; i += GT) { const int pos = i >> 6, k = i & 63, j = k & 31; const float p = (k < 32) ? (float)(pos >> 6) : (float)(pos & 63);
            const float f = expf(-(float)j * (9.210340371976184f / 32.f)); float s, c; sincos_(p * f, s, c); cosA[i] = c; sinA[i] = s; }
        for (int i = gid; i < 4096 * 32; i += GT) { const int pos = i >> 5, k = i & 31, j = k & 15; const float p = (k < 16) ? (float)(pos >> 6) : (float)(pos & 63);
            const float f = expf(-(float)j * (9.210340371976184f / 16.f)); float s, c; sincos_(p * f, s, c); cosB[i] = c; sinB[i] = s; }
        float* lb = (float*)(ws + WS_LB); float* sp8 = (float*)(ws + WS_SP8);
        for (int i = gid; i < 2048; i += GT) { const int d = i >> 10, w = i & 1023; const float l0 = P.in[I_LBL][(d * 2 + 0) * 1024 + w], l1 = P.in[I_LBL][(d * 2 + 1) * 1024 + w];
            lb[i] = 1.f / (1.f + expf(l0 - l1));
            const float e = expf(-P.in[I_LAM][i]); sp8[i] = 8.f * log1pf(e); }
        bf16* Wl = (bf16*)(ws + WS_WLRU);
        for (int i = gid; i < 65536; i += GT) { const int row = i >> 4, ch = i & 15, pn = row >> 8, nn = (pn >> 1) & 1;
            *(v4u*)(Wl + (size_t)row * 256 + (1 - nn) * 128 + ch * 8) = (v4u){0u, 0u, 0u, 0u}; }
    }
    {
        LAS float* scr = (LAS float*)(lds + wave * 16384);
        const int gw = bid * 8 + wave, NGW = G * 8;
        TrItem ta, tb; float ra[32], rb[32];
#define TR_LOAD(r, t) do { _Pragma("unroll") for (int i = 0; i < 32; ++i) r[i] = t.src[(size_t)(2 * i + (lane >> 5)) * t.N + (lane & 31)]; } while (0)
#define TR_PROC(r, t) do { _Pragma("unroll") for (int i = 0; i < 32; ++i) scr[(2 * i + (lane >> 5)) * 33 + (lane & 31)] = r[i]; \
        LDS_WAIT(); const int c_ = lane & 7; \
        _Pragma("unroll") for (int j = 0; j < 4; ++j) { const int n_ = (lane >> 3) + 8 * j; const LAS float* s_ = scr + (8 * c_) * 33 + n_; \
            v4u o_; o_.x = cvtpk(s_[0 * 33], s_[1 * 33]); o_.y = cvtpk(s_[2 * 33], s_[3 * 33]); o_.z = cvtpk(s_[4 * 33], s_[5 * 33]); o_.w = cvtpk(s_[6 * 33], s_[7 * 33]); \
            *(v4u*)(t.dst + (size_t)n_ * t.ldt + 8 * c_) = o_; } \
        LDS_WAIT(); } while (0)
        int g = gw;
        if (g < TR_TOTAL) {
            tr_decode(P, g, ta); TR_LOAD(ra, ta);
            for (;;) {
                const int g2 = g + NGW; const bool h2 = g2 < TR_TOTAL; if (h2) { tr_decode(P, g2, tb); TR_LOAD(rb, tb); }
                TR_PROC(ra, ta);
                if (!h2) break;
                const int g3 = g2 + NGW; const bool h3 = g3 < TR_TOTAL; if (h3) { tr_decode(P, g3, ta); TR_LOAD(ra, ta); }
                TR_PROC(rb, tb);
                if (!h3) break;
                g = g3;
            }
        }
#undef TR_LOAD
#undef TR_PROC
    }
}

template <int MODE>
__device__ __forceinline__ void norm_phase(const Params& P, const float* nw, const float* mod_sh  , bool lat_only, const float* part = nullptr  , bool ctx_in = false  ) {
    const int tid = threadIdx.x, lane = tid & 63, wave = tid >> 6, gw = blockIdx.x * 8 + wave, NGW = gridDim.x * 8;
    float* H = (float*)(P.ws + WS_H); bf16* U = (bf16*)(P.ws + WS_U);
    f32x4 w4[8];
#pragma unroll
    for (int j = 0; j < 8; ++j) w4[j] = ((const f32x4*)nw)[lane + 64 * j];
    for (int r = gw; r < MT; r += NGW) {
        const int b = r / TPB, tb = r - b * TPB; const bool isctx = tb < CTXL;
        if ((lat_only || MODE == 2) && isctx) continue;
        const float* src;
        if (MODE == 0) src = isctx ? P.in[I_CTX] + (size_t)(b * CTXL + tb) * DM : P.in[I_X] + (size_t)(b * SEQL + tb - CTXL) * DM;
        else src = (ctx_in && part != nullptr && isctx) ? P.in[I_CTX] + (size_t)(b * CTXL + tb) * DM : H + (size_t)r * DM;
        f32x4 v[8]; float s = 0.f;
#pragma unroll
        for (int j = 0; j < 8; ++j) { v[j] = ((const f32x4*)src)[lane + 64 * j]; s += (v[j].x * v[j].x + v[j].y * v[j].y) + (v[j].z * v[j].z + v[j].w * v[j].w); }
        if (MODE == 1 && part != nullptr && isctx) {
            s = 0.f;
#pragma unroll
            for (int j = 0; j < 8; ++j) {
#pragma unroll
                for (int q = 0; q < 4; ++q) v[j] += ((const f32x4*)(part + ((size_t)q * 1024 + b * CTXL + tb) * DM))[lane + 64 * j];
                s += (v[j].x * v[j].x + v[j].y * v[j].y) + (v[j].z * v[j].z + v[j].w * v[j].w);
                ((f32x4*)(H + (size_t)r * DM))[lane + 64 * j] = v[j]; } }
        const float rstd = rsqrtf(wave_sum(s) * (1.f / DM) + EPS);
        if (MODE == 2) {
            float* o = P.out + (size_t)(b * SEQL + tb - CTXL) * DM;
            float dlt = 0.f; if (TPH_LO >= 0 && b == 0 && tb - CTXL < 16) { const unsigned long long* ts = (const unsigned long long*)(P.ws + 15 * MiB); dlt = sqrtf((float)(ts[1] - ts[0]) * (0.01f / 20000.f)); }
#pragma unroll
            for (int j = 0; j < 8; ++j) ((f32x4*)o)[lane + 64 * j] = v[j] * rstd * w4[j] + dlt;
        } else {
            const float* sh = mod_sh + (size_t)(isctx ? 4 : b) * MODW; const float* sc = sh + DM;
#pragma unroll
            for (int j = 0; j < 8; ++j) { const f32x4 a = ((const f32x4*)sh)[lane + 64 * j], m = ((const f32x4*)sc)[lane + 64 * j];
                const f32x4 y = (v[j] * rstd * w4[j]) * (m + 1.f) + a;
                ((v2u*)(U + (size_t)r * DM))[lane + 64 * j] = (v2u){cvtpk(y.x, y.y), cvtpk(y.z, y.w)}; }
        }
    }
}
__device__ __forceinline__ void attn_post_phase(const Params& P) {
    const int tid = threadIdx.x, lane = tid & 63, wave = tid >> 6, gw = blockIdx.x * 8 + wave, NGW = gridDim.x * 8;
    unsigned char* ws = P.ws;
    const bf16* proj = (const bf16*)(ws + WS_PROJ); bf16* Qa = (bf16*)(ws + WS_QA); bf16* Ka = (bf16*)(ws + WS_KA);
    bf16* cqn = (bf16*)(ws + WS_CQN); bf16* ckvn = (bf16*)(ws + WS_CKVN); bf16* kr = (bf16*)(ws + WS_KR);
    const float* cosA = (const float*)(ws + WS_COSA); const float* sinA = (const float*)(ws + WS_SINA);
    const float* cosB = (const float*)(ws + WS_COSB); const float* sinB = (const float*)(ws + WS_SINB);
    const int hl = lane >> 5, l32 = lane & 31;
    const float qw0 = P.in[I_QNW][2 * l32], qw1 = P.in[I_QNW][2 * l32 + 1], qw2 = P.in[I_QNW][64 + 2 * l32], qw3 = P.in[I_QNW][64 + 2 * l32 + 1];
    const float kw0 = P.in[I_KNW][2 * l32], kw1 = P.in[I_KNW][2 * l32 + 1], kw2 = P.in[I_KNW][64 + 2 * l32], kw3 = P.in[I_KNW][64 + 2 * l32 + 1];
    for (int r = gw; r < MT; r += NGW) {
        const int b = r / TPB, tb = r - b * TPB; const bool lat = tb >= CTXL; const int pos = tb - CTXL;
        const bf16* pr = proj + (size_t)r * AIWP;
        float rc0 = 1.f, rc1 = 1.f, rs0 = 0.f, rs1 = 0.f;
        if (lat) { rc0 = cosA[pos * 64 + 2 * l32]; rc1 = cosA[pos * 64 + 2 * l32 + 1]; rs0 = sinA[pos * 64 + 2 * l32]; rs1 = sinA[pos * 64 + 2 * l32 + 1]; }
#pragma unroll
        for (int it = 0; it < 5; ++it) {
            const int hh = it * 2 + hl;
            const unsigned wa = *(const unsigned*)(pr + hh * 128 + 2 * l32), wb = *(const unsigned*)(pr + hh * 128 + 64 + 2 * l32);
            float a0 = bflo(wa), a1 = bfhi(wa), b0 = bflo(wb), b1 = bfhi(wb);
            float ss = a0 * a0 + a1 * a1 + b0 * b0 + b1 * b1;
#pragma unroll
            for (int o = 1; o < 32; o <<= 1) ss += __shfl_xor(ss, o);
            const float rstd = rsqrtf(ss * (1.f / 128.f) + EPS);
            const bool isq = hh < 8;
            a0 *= rstd * (isq ? qw0 : kw0); a1 *= rstd * (isq ? qw1 : kw1); b0 *= rstd * (isq ? qw2 : kw2); b1 *= rstd * (isq ? qw3 : kw3);
            if (lat) { const float c0 = rc0, c1 = rc1, s0 = rs0, s1 = rs1;
                const float x0 = a0 * c0 - b0 * s0, x1 = a1 * c1 - b1 * s1, y0 = b0 * c0 + a0 * s0, y1 = b1 * c1 + a1 * s1; a0 = x0; a1 = x1; b0 = y0; b1 = y1; }
            bf16* dst = (hh < 8) ? Qa + (size_t)r * 1024 + hh * 128 : Ka + (size_t)r * 256 + (hh - 8) * 128;
            *(unsigned*)(dst + 2 * l32) = cvtpk(a0, a1); *(unsigned*)(dst + 64 + 2 * l32) = cvtpk(b0, b1);
        }
#pragma unroll
        for (int which = 0; which < 2; ++which) {
            const v4u x = *(const v4u*)(pr + 1536 + which * 512 + lane * 8);
            float f[8]; float ss = 0.f;
#pragma unroll
            for (int e = 0; e < 4; ++e) { f[2 * e] = bflo(x[e]); f[2 * e + 1] = bfhi(x[e]); ss += f[2 * e] * f[2 * e] + f[2 * e + 1] * f[2 * e + 1]; }
            const float rstd = rsqrtf(wave_sum(ss) * (1.f / 512.f) + EPS);
            const float* nw = (which ? P.in[I_MKVNW] : P.in[I_MQNW]) + lane * 8;
            v4u o;
#pragma unroll
            for (int e = 0; e < 4; ++e) o[e] = cvtpk(f[2 * e] * rstd * nw[2 * e], f[2 * e + 1] * rstd * nw[2 * e + 1]);
            *(v4u*)((which ? ckvn : cqn) + (size_t)r * 512 + lane * 8) = o;
        }
        if (lane < 32) {
            float x1 = bf2f(pr[2560 + lane]), x2 = bf2f(pr[2592 + lane]);
            if (lat) { const float c = cosB[pos * 32 + lane], s = sinB[pos * 32 + lane]; const float y1 = x1 * c - x2 * s, y2 = x2 * c + x1 * s; x1 = y1; x2 = y2; }
            kr[(size_t)r * 64 + lane] = f2bf(x1); kr[(size_t)r * 64 + 32 + lane] = f2bf(x2);
        }
    }
}

__device__ __forceinline__ void attn_phase(const Params& P, char* lds) {
    unsigned char* ws = P.ws;
    const bf16* proj = (const bf16*)(ws + WS_PROJ); const bf16* Qa = (const bf16*)(ws + WS_QA); const bf16* Ka = (const bf16*)(ws + WS_KA);
    const bf16* kr = (const bf16*)(ws + WS_KR); const bf16* qb = (const bf16*)(ws + WS_QB); const bf16* kvb = (const bf16*)(ws + WS_KVB);
    bf16* mix = (bf16*)(ws + WS_MIX);
    const float* cosB = (const float*)(ws + WS_COSB); const float* sinB = (const float*)(ws + WS_SINB);
    const int w = blockIdx.x, G = gridDim.x;
    const float CA = 0.08838834764831845f * 1.4426950408889634f, TA = 8.f / 0.08838834764831845f;
    const float CB = 0.07216878364870323f * 1.4426950408889634f, TB = 8.f / 0.07216878364870323f;
    for (int u = w; u < 512 + 32; u += G) {
        __syncthreads();
        int b, h, qblk; bool isctx = false;
        if (u < 512) { const int r = u >> 8, ww = u & 255, grp = r * 4 + ((ww & 7) >> 1), idx = ((ww & 7) & 1) * 32 + (ww >> 3);
            b = grp >> 1; h = (grp & 1) * 4 + (idx >> 4); qblk = idx & 15; }
        else { const int v = u - 512; b = v >> 3; h = v & 7; qblk = 0; isctx = true; }
        const size_t row0 = (size_t)b * TPB, qrow = isctx ? row0 : row0 + CTXL + qblk * 256; const int seq = isctx ? CTXL : TPB;
        const int kvh = h >> 2;
        attn::attn_body<128, 1024, 256, AIWP>(Qa + qrow * 1024 + h * 128, Ka + row0 * 256 + kvh * 128, nullptr, proj + row0 * AIWP + 1280 + kvh * 128,
                                              mix + qrow * 2048 + h * 128, seq, lds, CA, TA, nullptr, nullptr);
    }
    for (int u0 = w; u0 < 512 + 256; u0 += G) {
        int u = u0; if (u0 >= 512) { if (u0 < 512 + 32 || u0 >= 512 + 64) continue; u = u0 - 32; }
        __syncthreads();
        int b, h, qblk; bool isctx = false;
        if (u < 512) { const int r = u >> 8, ww = u & 255, grp = r * 16 + (ww & 7) * 2 + ((ww >> 3) >> 4);
            b = grp >> 3; h = grp & 7; qblk = (ww >> 3) & 15; }
        else { const int v = u - 512; b = v >> 3; h = v & 7; qblk = 0; isctx = true; }
        const size_t row0 = (size_t)b * TPB, qrow = isctx ? row0 : row0 + CTXL + qblk * 256; const int seq = isctx ? CTXL : TPB;
        attn::attn_body<192, 1536, 2048, 2048>(qb + qrow * 1536 + h * 192, kvb + row0 * 2048 + h * 256, kr + row0 * 64, kvb + row0 * 2048 + h * 256 + 128,
                                               mix + qrow * 2048 + 1024 + h * 128, seq, lds, CB, TB, isctx ? nullptr : cosB + (size_t)qblk * 256 * 32, isctx ? nullptr : sinB + (size_t)qblk * 256 * 32);
    }
}

__device__ __forceinline__ void conv_phase(const Params& P) {
    const bf16* prec = (const bf16*)(P.ws + WS_PREC); bf16* xc = (bf16*)(P.ws + WS_XC);
    const float* cw = P.in[I_CONVW]; const float* cb = P.in[I_CONVB];
    const int GT = gridDim.x * 512;
    const int c8 = ((int)threadIdx.x & 127) * 8;
    float wv[4][8], bv[8];
#pragma unroll
    for (int e = 0; e < 8; ++e) { bv[e] = cb[c8 + e];
#pragma unroll
        for (int j = 0; j < 4; ++j) wv[j][e] = cw[j * 1024 + c8 + e]; }
    for (int idx = blockIdx.x * 512 + threadIdx.x; idx < MT * 128; idx += GT) {
        const int row = idx >> 7, tb = row % TPB, lo = tb < CTXL ? 0 : CTXL, hi = tb < CTXL ? CTXL : TPB;
        float acc[8];
#pragma unroll
        for (int e = 0; e < 8; ++e) acc[e] = bv[e];
#pragma unroll
        for (int j = 0; j < 4; ++j) { const int t2 = tb + j - 2;
            if (t2 >= lo && t2 < hi) { const v4u x = *(const v4u*)(prec + (size_t)(row + j - 2) * PRW + c8);
#pragma unroll
                for (int e = 0; e < 4; ++e) { acc[2 * e] += wv[j][2 * e] * bflo(x[e]); acc[2 * e + 1] += wv[j][2 * e + 1] * bfhi(x[e]); } } }
        *(v4u*)(xc + (size_t)row * 1024 + c8) = (v4u){cvtpk(acc[0], acc[1]), cvtpk(acc[2], acc[3]), cvtpk(acc[4], acc[5]), cvtpk(acc[6], acc[7])};
    }
}
typedef float f32x4m __attribute__((ext_vector_type(4)));
__device__ __forceinline__ void hg_a_phase(const Params& P, LAS unsigned char* lds) {
    const bf16* HG = (const bf16*)(P.ws + WS_HG); bf16* SS = (bf16*)(P.ws + WS_SS); float* HGD = (float*)(P.ws + WS_HGD); const float* lb = (const float*)(P.ws + WS_LB);
    LAS bf16* Kt = (LAS bf16*)lds;
    LAS bf16* Vt = (LAS bf16*)(lds + 36864);
    LAS float* segt = (LAS float*)(lds + 55296);
    const int tid = threadIdx.x, lane = tid & 63, wid = tid >> 6, fr = lane & 15, fq = lane >> 4;
    const int sdir = tid >> 8, half = (tid >> 7) & 1, d = tid & 127;
    v4u xv[2]; bf16 pfv[32];
#define HGA_LOAD(task_) do { const int rc_ = (task_) % 68, bh_ = (task_) / 68, b_ = bh_ >> 3, h_ = bh_ & 7; \
        _Pragma("unroll") for (int i = 0; i < 2; ++i) { const int id = tid + 512 * i, r = id >> 4, v8 = (id & 15) * 8; xv[i] = *(const v4u*)(HG + ((((size_t)3 * 4 + b_) * 8 + h_) * 4352 + rc_ * 64 + r) * 128 + v8); } \
        const bf16* pf_ = HG + ((((size_t)(1 + sdir) * 4 + b_) * 8 + h_) * 4352 + rc_ * 64 + half * 32) * 128 + d; \
        _Pragma("unroll") for (int e = 0; e < 32; ++e) pfv[e] = pf_[e * 128]; } while (0)
    if ((int)blockIdx.x < NBATCH * 8 * 68) HGA_LOAD((int)blockIdx.x);
    for (int task = blockIdx.x; task < NBATCH * 8 * 68; task += gridDim.x) {
        const int rc = task % 68, bh = task / 68, b = bh >> 3, h = bh & 7;
        __syncthreads();
#pragma unroll
        for (int i = 0; i < 2; ++i) { const int id = tid + 512 * i, r = id >> 4, v8 = (id & 15) * 8;
#pragma unroll
            for (int e = 0; e < 4; ++e) { Vt[(v8 + 2 * e) * 72 + r] = (bf16)(xv[i][e] & 0xffffu); Vt[(v8 + 2 * e + 1) * 72 + r] = (bf16)(xv[i][e] >> 16); } }
        float kh[32]; float E = 0.f;
        { const float lbv = lb[sdir * 1024 + h * 128 + d];
#pragma unroll
          for (int e = 0; e < 32; ++e) { const int ix = sdir ? e : 31 - e; const float x = bf2f(pfv[ix]);
              const float sg = sigmoidf_(x), f = lbv + (1.f - lbv) * sg, kk = (1.f - lbv) * (1.f - sg);
              kh[ix] = kk * __expf(E); E += __logf(f); } }
        segt[(sdir * 2 + half) * 128 + d] = E;
        if (task + (int)gridDim.x < NBATCH * 8 * 68) HGA_LOAD(task + (int)gridDim.x);
        __syncthreads();
        { const float To = segt[(sdir * 2 + (1 - half)) * 128 + d]; const bool need = sdir ? (half == 1) : (half == 0); const float mul = need ? __expf(To) : 1.f;
#pragma unroll
          for (int e = 0; e < 16; ++e) *(LAS unsigned*)(Kt + (sdir * 128 + d) * 72 + half * 32 + 2 * e) = cvtpk(kh[2 * e] * mul, kh[2 * e + 1] * mul);
          if (half == 0) HGD[((size_t)(bh * 2 + sdir) * 68 + rc) * 128 + d] = __expf(E + To); }
        __syncthreads();
        const int dir = wid >> 2, dt0 = (wid & 3) * 2;
        bf16x8 a[2][2];
#pragma unroll
        for (int t = 0; t < 2; ++t)
#pragma unroll
            for (int ks = 0; ks < 2; ++ks) a[t][ks] = *(const LAS bf16x8*)(Kt + (dir * 128 + (dt0 + t) * 16 + fr) * 72 + ks * 32 + fq * 8);
        bf16* out = SS + ((size_t)(bh * 2 + dir) * 68 + rc) * 16384;
#pragma unroll
        for (int vt = 0; vt < 8; ++vt) {
            bf16x8 bb[2];
#pragma unroll
            for (int ks = 0; ks < 2; ++ks) bb[ks] = *(const LAS bf16x8*)(Vt + (vt * 16 + fr) * 72 + ks * 32 + fq * 8);
#pragma unroll
            for (int t = 0; t < 2; ++t) { f32x4m c = {0.f, 0.f, 0.f, 0.f};
                c = __builtin_amdgcn_mfma_f32_16x16x32_bf16(a[t][0], bb[0], c, 0, 0, 0); c = __builtin_amdgcn_mfma_f32_16x16x32_bf16(a[t][1], bb[1], c, 0, 0, 0);
                *(v2u*)(out + (vt * 16 + fr) * 128 + (dt0 + t) * 16 + 4 * fq) = (v2u){cvtpk(c[0], c[1]), cvtpk(c[2], c[3])}; }
        }
    }
}
#undef HGA_LOAD
__device__ __forceinline__ void hg_b_phase(const Params& P) {
    bf16* SS = (bf16*)(P.ws + WS_SS); const float* HGD = (const float*)(P.ws + WS_HGD);
    const int GT = gridDim.x * 512;
    for (int t = blockIdx.x * 512 + threadIdx.x; t < 64 * 2048; t += GT) {
        const int seq = t >> 11, v = (t >> 4) & 127, d8 = (t & 15) * 8, dir = seq & 1;
        float S[8];
#pragma unroll
        for (int e = 0; e < 8; ++e) S[e] = 0.f;
        for (int j0 = 0; j0 < 72; j0 += 8) {
            v4u x[8]; f32x4 d0[8], d1[8]; bf16* p[8];
#pragma unroll
            for (int q = 0; q < 8; ++q) { const int j = j0 + q; if (j < 68) { const int rc = dir ? (j < 4 ? 3 - j : 71 - j) : j;
                p[q] = SS + ((size_t)seq * 68 + rc) * 16384 + v * 128 + d8; x[q] = *(const v4u*)p[q];
                const float* dp = HGD + ((size_t)seq * 68 + rc) * 128 + d8; d0[q] = *(const f32x4*)dp; d1[q] = *(const f32x4*)(dp + 4); } }
#pragma unroll
            for (int q = 0; q < 8; ++q) { if (j0 + q < 68) {
                *(v4u*)p[q] = (v4u){cvtpk(S[0], S[1]), cvtpk(S[2], S[3]), cvtpk(S[4], S[5]), cvtpk(S[6], S[7])};
#pragma unroll
                for (int e = 0; e < 4; ++e) { S[2 * e] = (e < 2 ? d0[q][2 * e] : d1[q][2 * e - 4]) * S[2 * e] + bflo(x[q][e]); S[2 * e + 1] = (e < 2 ? d0[q][2 * e + 1] : d1[q][2 * e - 3]) * S[2 * e + 1] + bfhi(x[q][e]); } } }
        }
    }
}
__device__ __forceinline__ void hg_c_phase(const Params& P, LAS unsigned char* lds) {
    const bf16* HG = (const bf16*)(P.ws + WS_HG); const bf16* SS = (const bf16*)(P.ws + WS_SS); const float* lb = (const float*)(P.ws + WS_LB); bf16* mix = (bf16*)(P.ws + WS_MIX);
    LAS bf16* qs = (LAS bf16*)lds;
    LAS bf16* Vt = (LAS bf16*)(lds + 17408);
    LAS float* cum = (LAS float*)(lds + 35840);
    LAS bf16* ksm = (LAS bf16*)(lds + 69632);
    LAS float* red = (LAS float*)(lds + 105472);
    LAS float* segt = (LAS float*)(lds + 105984);
    LAS bf16* Ss = (LAS bf16*)(lds + 108032);
    const int tid = threadIdx.x, lane = tid & 63, wid = tid >> 6, fr = lane & 15, fq = lane >> 4, ti = wid & 3, vh = wid >> 2;
    const int seg = tid >> 7, dd = tid & 127;
    LAS bf16* Pw = (LAS bf16*)(lds + 87040) + wid * 1152;
    for (int task = blockIdx.x; task < NBATCH * 8 * 64; task += gridDim.x) {
        const int rc = 4 + (task & 63), bh = task >> 6, b = bh >> 3, h = bh & 7; const size_t R0 = (size_t)b * TPB + rc * 64;
        const bf16* hq = HG + ((((size_t)0 * 4 + b) * 8 + h) * 4352 + rc * 64) * 128; const size_t SECS = (size_t)4 * 8 * 4352 * 128;
        __syncthreads();
        v4u xv[2], xq[2], sreg[4]; bf16 pf0[16], pf1[16], gg[16];
#pragma unroll
        for (int i = 0; i < 2; ++i) { const int id = tid + 512 * i, r = id >> 4, v8 = (id & 15) * 8;
            xv[i] = *(const v4u*)(hq + 3 * SECS + r * 128 + v8); xq[i] = *(const v4u*)(hq + r * 128 + v8); }
#pragma unroll
        for (int e = 0; e < 16; ++e) { const bf16* pp = hq + SECS + (seg * 16 + e) * 128 + dd; pf0[e] = pp[0]; pf1[e] = pp[SECS]; }
#pragma unroll
        for (int i = 0; i < 4; ++i) { const int id = tid + 512 * i; sreg[i] = *(const v4u*)(SS + ((size_t)(bh * 2 + 0) * 68 + rc) * 16384 + (id >> 4) * 128 + (id & 15) * 8); }
#pragma unroll
        for (int vt = 0; vt < 4; ++vt)
#pragma unroll
            for (int j = 0; j < 4; ++j) gg[vt * 4 + j] = hq[4 * SECS + (16 * ti + 4 * fq + j) * 128 + vh * 64 + vt * 16 + fr];
#pragma unroll
        for (int i = 0; i < 2; ++i) { const int id = tid + 512 * i, r = id >> 4, v8 = (id & 15) * 8;
#pragma unroll
            for (int e = 0; e < 4; ++e) { Vt[(v8 + 2 * e) * 72 + r] = (bf16)(xv[i][e] & 0xffffu); Vt[(v8 + 2 * e + 1) * 72 + r] = (bf16)(xv[i][e] >> 16); }
            v4u o;
#pragma unroll
            for (int e = 0; e < 4; ++e) o[e] = cvtpk(siluf_(bflo(xq[i][e])), siluf_(bfhi(xq[i][e])));
            *(LAS v4u*)(qs + r * 136 + v8) = o; }
        f32x4m oacc[4];
#pragma unroll
        for (int vt = 0; vt < 4; ++vt) oacc[vt] = (f32x4m){0.f, 0.f, 0.f, 0.f};
#pragma unroll
        for (int dir = 0; dir < 2; ++dir) {
            __syncthreads();
            float lc[16];
            { const float lbv = lb[dir * 1024 + h * 128 + dd]; float c = 0.f;
#pragma unroll
              for (int e = 0; e < 16; ++e) { const int ix = dir ? 15 - e : e; const float x = bf2f(dir ? pf1[ix] : pf0[ix]);
                  const float sg = sigmoidf_(x), f = lbv + (1.f - lbv) * sg, kk = (1.f - lbv) * (1.f - sg);
                  c += __logf(f); lc[ix] = c; ksm[(seg * 16 + ix) * 136 + dd] = f2bf(kk); }
              segt[seg * 128 + dd] = c; }
#pragma unroll
            for (int i = 0; i < 4; ++i) { const int id = tid + 512 * i; *(LAS v4u*)(Ss + (id >> 4) * 136 + (id & 15) * 8) = sreg[i]; }
            __syncthreads();
            { float pre = 0.f;
#pragma unroll
              for (int s2 = 0; s2 < 4; ++s2) { const bool take = dir ? (s2 > seg) : (s2 < seg); pre += take ? segt[s2 * 128 + dd] : 0.f; }
#pragma unroll
              for (int e = 0; e < 16; ++e) cum[(seg * 16 + e) * 132 + dd] = lc[e] + pre; }
            if (dir == 0) {
#pragma unroll
                for (int i = 0; i < 4; ++i) { const int id = tid + 512 * i; sreg[i] = *(const v4u*)(SS + ((size_t)(bh * 2 + 1) * 68 + rc) * 16384 + (id >> 4) * 128 + (id & 15) * 8); } }
            __syncthreads();
            const int refrow = dir ? 16 * (ti + 1) : 16 * ti - 1; const bool hasref = dir ? (ti < 3) : (ti > 0);
            bf16x8 Qt[4], Qh[4];
#pragma unroll
            for (int k4 = 0; k4 < 4; ++k4) { const int i = 16 * ti + fr, d = k4 * 32 + fq * 8;
                const v4u qw = *(const LAS v4u*)(qs + i * 136 + d);
                const f32x4 c0 = *(const LAS f32x4*)(cum + i * 132 + d), c1 = *(const LAS f32x4*)(cum + i * 132 + d + 4);
                f32x4 r0 = {0.f, 0.f, 0.f, 0.f}, r1 = {0.f, 0.f, 0.f, 0.f};
                if (hasref) { r0 = *(const LAS f32x4*)(cum + refrow * 132 + d); r1 = *(const LAS f32x4*)(cum + refrow * 132 + d + 4); }
                v4u wt, wh;
#pragma unroll
                for (int e = 0; e < 4; ++e) { const float qa = bflo(qw[e]), qb_ = bfhi(qw[e]);
                    const float ca = e < 2 ? c0[2 * e] : c1[2 * e - 4], cb_ = e < 2 ? c0[2 * e + 1] : c1[2 * e - 3];
                    const float ra = e < 2 ? r0[2 * e] : r1[2 * e - 4], rb = e < 2 ? r0[2 * e + 1] : r1[2 * e - 3];
                    wt[e] = cvtpk(qa * __expf(ca - ra), qb_ * __expf(cb_ - rb)); wh[e] = cvtpk(qa * __expf(ca), qb_ * __expf(cb_)); }
                Qt[k4] = *reinterpret_cast<bf16x8*>(&wt); Qh[k4] = *reinterpret_cast<bf16x8*>(&wh); }
#pragma unroll
            for (int sj = 0; sj < 4; ++sj) {
                const bool att = dir ? (sj >= ti) : (sj <= ti);
                f32x4m sc = {0.f, 0.f, 0.f, 0.f};
                if (att) {
#pragma unroll
                    for (int k4 = 0; k4 < 4; ++k4) { const int i2 = 16 * sj + fr, d = k4 * 32 + fq * 8;
                        const v4u kw = *(const LAS v4u*)(ksm + i2 * 136 + d);
                        const f32x4 c0 = *(const LAS f32x4*)(cum + i2 * 132 + d), c1 = *(const LAS f32x4*)(cum + i2 * 132 + d + 4);
                        f32x4 r0 = {0.f, 0.f, 0.f, 0.f}, r1 = {0.f, 0.f, 0.f, 0.f};
                        if (hasref) { r0 = *(const LAS f32x4*)(cum + refrow * 132 + d); r1 = *(const LAS f32x4*)(cum + refrow * 132 + d + 4); }
                        v4u wk;
#pragma unroll
                        for (int e = 0; e < 4; ++e) { const float ka = bflo(kw[e]), kb_ = bfhi(kw[e]);
                            const float ca = e < 2 ? c0[2 * e] : c1[2 * e - 4], cb_ = e < 2 ? c0[2 * e + 1] : c1[2 * e - 3];
                            const float ra = e < 2 ? r0[2 * e] : r1[2 * e - 4], rb = e < 2 ? r0[2 * e + 1] : r1[2 * e - 3];
                            wk[e] = cvtpk(ka * __expf(ra - ca), kb_ * __expf(rb - cb_)); }
                        sc = __builtin_amdgcn_mfma_f32_16x16x32_bf16(Qt[k4], *reinterpret_cast<bf16x8*>(&wk), sc, 0, 0, 0); }
                    if (sj == ti) {
#pragma unroll
                        for (int j = 0; j < 4; ++j) { const bool keep = dir ? (fr >= 4 * fq + j) : (fr <= 4 * fq + j); sc[j] = keep ? sc[j] : 0.f; } }
                }
#pragma unroll
                for (int j = 0; j < 4; ++j) Pw[(4 * fq + j) * 72 + 16 * sj + fr] = f2bf(sc[j]);
            }
            LDS_WAIT(); __builtin_amdgcn_wave_barrier();
#pragma unroll
            for (int ks = 0; ks < 2; ++ks) { const bf16x8 pa = *(const LAS bf16x8*)(Pw + fr * 72 + ks * 32 + fq * 8);
#pragma unroll
                for (int vt = 0; vt < 4; ++vt) { const bf16x8 vb = *(const LAS bf16x8*)(Vt + (vh * 64 + vt * 16 + fr) * 72 + ks * 32 + fq * 8);
                    oacc[vt] = __builtin_amdgcn_mfma_f32_16x16x32_bf16(pa, vb, oacc[vt], 0, 0, 0); } }
#pragma unroll
            for (int k4 = 0; k4 < 4; ++k4)
#pragma unroll
                for (int vt = 0; vt < 4; ++vt) { const bf16x8 sb = *(const LAS bf16x8*)(Ss + (vh * 64 + vt * 16 + fr) * 136 + k4 * 32 + fq * 8);
                    oacc[vt] = __builtin_amdgcn_mfma_f32_16x16x32_bf16(Qh[k4], sb, oacc[vt], 0, 0, 0); }
        }
        float ssq[4];
#pragma unroll
        for (int j = 0; j < 4; ++j) { float s = 0.f;
#pragma unroll
            for (int vt = 0; vt < 4; ++vt) s += oacc[vt][j] * oacc[vt][j];
            s += __shfl_xor(s, 1); s += __shfl_xor(s, 2); s += __shfl_xor(s, 4); s += __shfl_xor(s, 8); ssq[j] = s; }
        if (fr == 0) {
#pragma unroll
            for (int j = 0; j < 4; ++j) red[(ti * 2 + vh) * 16 + 4 * fq + j] = ssq[j]; }
        __syncthreads();
#pragma unroll
        for (int j = 0; j < 4; ++j) { const int i = 16 * ti + 4 * fq + j;
            const float tot = red[(ti * 2) * 16 + 4 * fq + j] + red[(ti * 2 + 1) * 16 + 4 * fq + j]; const float rstd = rsqrtf(tot * (1.f / 128.f) + EPS);
#pragma unroll
            for (int vt = 0; vt < 4; ++vt) { const int v = vh * 64 + vt * 16 + fr;
                mix[(R0 + i) * 2048 + 1024 + h * 128 + v] = f2bf(oacc[vt][j] * rstd * P.in[I_HGNW][h * 128 + v] * siluf_(bf2f(gg[vt * 4 + j]))); } }
    }
}
__device__ __forceinline__ void lru_ab(float ra, float ix, float xc, float rab, float ixb, float sp, float& la, float& bb, float& a) {
    const float r = sigmoidf_(ra + rab), ig = sigmoidf_(ix + ixb); la = -r * sp; a = __expf(la);
    bb = __builtin_amdgcn_sqrtf(fmaxf(fmaf(-a, a, 1.f), 0.f)) * (ig * xc);
}
template <int NCH>
__device__ __forceinline__ void lru_s1_body(const Params& P, int bd, int rc, int ch) {
    const bf16* pre = (const bf16*)(P.ws + WS_LAB); const bf16* xcb = (const bf16*)(P.ws + WS_XC); float2* carr = (float2*)(P.ws + WS_CARR); const float* sp8 = (const float*)(P.ws + WS_SP8);
    const int b = bd >> 1, dir = bd & 1, nb = ch >> 7;
    const size_t R0 = (size_t)b * TPB + rc * 64;
    const bf16* pr = pre + R0 * 4096 + ((nb >> 1) * 4 + (nb & 1) * 2 + dir) * 256 + (ch & 127); const bf16* px = xcb + R0 * 1024 + ch;
    float rab[NCH], ixb[NCH], sp[NCH], A[NCH], hh[NCH];
#pragma unroll
    for (int c = 0; c < NCH; ++c) { rab[c] = P.in[I_RAB][dir * 1024 + ch + c]; ixb[c] = P.in[I_IXB][dir * 1024 + ch + c]; sp[c] = sp8[dir * 1024 + ch + c]; A[c] = 0.f; hh[c] = 0.f; }
    constexpr int NW = NCH / 2, RB = (NCH == 8) ? 4 : 16;
    for (int i0 = 0; i0 < 64; i0 += RB) {
        unsigned w0[RB][NW], w1[RB][NW], w2[RB][NW];
#pragma unroll
        for (int e = 0; e < RB; ++e) { const int r = dir ? (63 - i0 - e) : (i0 + e);
            if constexpr (NCH == 8) { const v4u x0 = *(const v4u*)(pr + (size_t)r * 4096), x1 = *(const v4u*)(pr + (size_t)r * 4096 + 128), x2 = *(const v4u*)(px + (size_t)r * 1024);
#pragma unroll
                for (int q = 0; q < 4; ++q) { w0[e][q] = x0[q]; w1[e][q] = x1[q]; w2[e][q] = x2[q]; } }
            else { w0[e][0] = *(const unsigned*)(pr + (size_t)r * 4096); w1[e][0] = *(const unsigned*)(pr + (size_t)r * 4096 + 128); w2[e][0] = *(const unsigned*)(px + (size_t)r * 1024); } }
#pragma unroll
        for (int e = 0; e < RB; ++e)
#pragma unroll
            for (int c = 0; c < NCH; ++c) { const unsigned a0 = w0[e][c >> 1], a1 = w1[e][c >> 1], a2 = w2[e][c >> 1];
                float la, bb, av; lru_ab((c & 1) ? bfhi(a0) : bflo(a0), (c & 1) ? bfhi(a1) : bflo(a1), (c & 1) ? bfhi(a2) : bflo(a2), rab[c], ixb[c], sp[c], la, bb, av);
                A[c] += la; hh[c] = av * hh[c] + bb; }
    }
    float2* cp = carr + ((size_t)bd * 68 + rc) * 1024 + ch;
#pragma unroll
    for (int c = 0; c < NCH; ++c) cp[c] = make_float2(A[c], hh[c]);
}
__device__ __forceinline__ void lru_s1_phase(const Params& P) {
    const int tid = threadIdx.x, wave = tid >> 6, lane = tid & 63, G = gridDim.x, bid = blockIdx.x;
    if (G == 256) {
        if (wave < 4) { const int t = (wave * 256 + bid) * 64 + lane; lru_s1_body<8>(P, t >> 13, 4 + ((t >> 7) & 63), (t & 127) * 8); }
        else if (wave == 4) { const int t = bid * 64 + lane; lru_s1_body<2>(P, t >> 11, (t >> 9) & 3, (t & 511) * 2); }
    } else {
        const int GT = G * 512;
        for (int t = (wave * G + bid) * 64 + lane; t < NBATCH * 2 * 68 * 128; t += GT) lru_s1_body<8>(P, (t >> 7) / 68, (t >> 7) % 68, (t & 127) * 8);
    }
}
__device__ __forceinline__ void lru_prefix_phase(const Params& P) {
    float2* carr = (float2*)(P.ws + WS_CARR);
    const int t = (((int)threadIdx.x >> 6) * (int)gridDim.x + (int)blockIdx.x) * 64 + ((int)threadIdx.x & 63);
    if (t < NBATCH * 2 * 1024) {
        const int ch = t & 1023, bd = t >> 10, dir = bd & 1;
        float2* cp = carr + (size_t)bd * 68 * 1024 + ch;
        float hh = 0.f;
        for (int j0 = 0; j0 < 68; j0 += 17) {
            float2 ab[17];
#pragma unroll
            for (int q = 0; q < 17; ++q) { const int j = j0 + q, rc = dir ? (j < 4 ? 3 - j : 71 - j) : j; ab[q] = cp[(size_t)rc * 1024]; }
#pragma unroll
            for (int q = 0; q < 17; ++q) { const int j = j0 + q, rc = dir ? (j < 4 ? 3 - j : 71 - j) : j; cp[(size_t)rc * 1024].y = hh; hh = __expf(ab[q].x) * hh + ab[q].y; }
        }
    }
}
__device__ __forceinline__ float gelu_tanh_(float x) { return x * sigmoidf_(1.5957691216057308f * (x + 0.044715f * x * x * x)); }
__device__ __forceinline__ void lru_s2_phase(const Params& P, LAS unsigned char* lds) {
    const bf16* pre = (const bf16*)(P.ws + WS_LAB); const bf16* xcb = (const bf16*)(P.ws + WS_XC); const float2* carr = (const float2*)(P.ws + WS_CARR); const float* sp8 = (const float*)(P.ws + WS_SP8);
    const bf16* prec = (const bf16*)(P.ws + WS_PREC); bf16* mix = (bf16*)(P.ws + WS_MIX); bf16* hfs = (bf16*)(P.ws + WS_XC + 34 * MiB);
    const int tid = threadIdx.x, GT = gridDim.x * 512;
    for (int t = ((tid >> 6) * (int)gridDim.x + (int)blockIdx.x) * 64 + (tid & 63); t < NBATCH * 64 * 256; t += GT) {
        const int ch = (t & 255) * 4, rc = 4 + ((t >> 8) & 63), b = t >> 14, nb = ch >> 7; const size_t R0 = (size_t)b * TPB + rc * 64;
        const bf16* px = xcb + R0 * 1024 + ch;
#pragma unroll
        for (int dir = 0; dir < 2; ++dir) {
            const bf16* pr = pre + R0 * 4096 + ((nb >> 1) * 4 + (nb & 1) * 2 + dir) * 256 + (ch & 127);
            float rab[4], ixb[4], sp[4], hh[4];
#pragma unroll
            for (int c = 0; c < 4; ++c) { rab[c] = P.in[I_RAB][dir * 1024 + ch + c]; ixb[c] = P.in[I_IXB][dir * 1024 + ch + c]; sp[c] = sp8[dir * 1024 + ch + c];
                hh[c] = carr[((size_t)(b * 2 + dir) * 68 + rc) * 1024 + ch + c].y; }
            for (int i0 = 0; i0 < 64; i0 += 8) {
                v2u w0[8], w1[8], w2[8], gt[8], hf[8];
#pragma unroll
                for (int e = 0; e < 8; ++e) { const int r = dir ? (63 - i0 - e) : (i0 + e); w0[e] = *(const v2u*)(pr + (size_t)r * 4096); w1[e] = *(const v2u*)(pr + (size_t)r * 4096 + 128); w2[e] = *(const v2u*)(px + (size_t)r * 1024);
                    if (dir) { gt[e] = *(const v2u*)(prec + (R0 + r) * PRW + 1024 + ch); hf[e] = *(const v2u*)(hfs + (R0 + r) * 1024 + ch); } }
#pragma unroll
                for (int e = 0; e < 8; ++e) { const int r = dir ? (63 - i0 - e) : (i0 + e); float o[4];
#pragma unroll
                    for (int c = 0; c < 4; ++c) { const unsigned a0 = w0[e][c >> 1], a1 = w1[e][c >> 1], a2 = w2[e][c >> 1];
                        float la, bb, av; lru_ab((c & 1) ? bfhi(a0) : bflo(a0), (c & 1) ? bfhi(a1) : bflo(a1), (c & 1) ? bfhi(a2) : bflo(a2), rab[c], ixb[c], sp[c], la, bb, av);
                        hh[c] = av * hh[c] + bb;
                        if (dir) { const unsigned g = gt[e][c >> 1], f = hf[e][c >> 1]; o[c] = gelu_tanh_((c & 1) ? bfhi(g) : bflo(g)) * (((c & 1) ? bfhi(f) : bflo(f)) + hh[c]); } else o[c] = hh[c]; }
                    *(v2u*)((dir ? mix + (R0 + r) * 2048 : hfs + (R0 + r) * 1024) + ch) = (v2u){cvtpk(o[0], o[1]), cvtpk(o[2], o[3])}; }
            }
        }
    }
}

#define XB_TMO      128
#define XB_XCNT(j)  (256  + 64 * (j))
#define XB_XSUB(j)  (1280 + 64 * (j))
#define XB_XGEN(j)  (2304 + 64 * (j))
#define XB_TOP      3328
#define XB_TOPGEN   3392
#define XCD_BAR_WORDS 3456
#define XB_SPIN_CAP (1u << 18)

__device__ __forceinline__ unsigned xb_ld(unsigned* p)              { return __hip_atomic_load(p, __ATOMIC_RELAXED, __HIP_MEMORY_SCOPE_AGENT); }
__device__ __forceinline__ unsigned xb_add(unsigned* p, unsigned v) { return __hip_atomic_fetch_add(p, v, __ATOMIC_RELAXED, __HIP_MEMORY_SCOPE_AGENT); }
__device__ __forceinline__ unsigned xb_xcc_id() { return (unsigned)__builtin_amdgcn_s_getreg((3 << 11) | 20) & 0xFu; }
#define XB_SPIN(cond, bar) do { unsigned _sp = 0; while (cond) { __builtin_amdgcn_s_sleep(1); \
    if ((++_sp & 255u) == 0u) { if (xb_ld(&(bar)[XB_TMO])) break; if (_sp > XB_SPIN_CAP) { atomicAdd(&(bar)[XB_TMO], 1u); break; } } } } while (0)

struct XcdBarrier {
    unsigned* bar; unsigned x;
    volatile LAS unsigned* st;
};

__device__ __forceinline__ XcdBarrier xcd_barrier_post(unsigned* bar, volatile LAS unsigned* st) {
    XcdBarrier b; b.bar = bar; b.x = xb_xcc_id(); b.st = st;
    if (threadIdx.x == 0) (void)xb_add(&bar[XB_XCNT(b.x)], 1u);
    return b;
}
__device__ __forceinline__ void xcd_barrier_complete(unsigned* bar, unsigned x, unsigned& nloc, unsigned& nx) {
    const unsigned G = gridDim.x * gridDim.y * gridDim.z;
    unsigned sum, cnt, mine, sp = 0u;
    for (;;) {
        sum = 0u; cnt = 0u; mine = 0u;
#pragma unroll
        for (unsigned j = 0; j < 16; ++j) { const unsigned c = xb_ld(&bar[XB_XCNT(j)]); sum += c; cnt += (c > 0u) ? 1u : 0u; mine = (j == x) ? c : mine; }
        if (sum == G) break;
        __builtin_amdgcn_s_sleep(1);
        if ((++sp & 255u) == 0u) { if (xb_ld(&bar[XB_TMO])) break; if (sp > XB_SPIN_CAP) { atomicAdd(&bar[XB_TMO], 1u); break; } }
    }
    nloc = mine > 0u ? mine : 1u; nx = cnt > 0u ? cnt : 1u;
}

__device__ __forceinline__ void xcd_barrier(const XcdBarrier& b) {
    asm volatile("s_waitcnt vmcnt(0)" ::: "memory");
    __syncthreads();
    if (threadIdx.x == 0) {
        unsigned* bar = b.bar;
        __builtin_amdgcn_s_waitcnt(0);
        unsigned nloc = b.st[0], nx = b.st[1];
        if (nloc == 0u) { xcd_barrier_complete(bar, b.x, nloc, nx); b.st[0] = nloc; b.st[1] = nx; }
        const unsigned old = xb_add(&bar[XB_XSUB(b.x)], 1u);
        const unsigned gen = old / nloc;
        if (old + 1u == (gen + 1u) * nloc) {
            __builtin_amdgcn_fence(__ATOMIC_RELEASE, "agent");
            asm volatile("s_waitcnt vmcnt(0)" ::: "memory");
            const unsigned og = xb_add(&bar[XB_TOP], 1u);
            const unsigned tg = og / nx;
            if (og + 1u == (tg + 1u) * nx) xb_add(&bar[XB_TOPGEN], 1u);
            else XB_SPIN(xb_ld(&bar[XB_TOPGEN]) == tg, bar);
            __builtin_amdgcn_fence(__ATOMIC_ACQUIRE, "agent");
            xb_add(&bar[XB_XGEN(b.x)], 1u);
            asm volatile("s_waitcnt vmcnt(0)" ::: "memory");
        } else {
            XB_SPIN(xb_ld(&bar[XB_XGEN(b.x)]) == gen, bar);
            __builtin_amdgcn_fence(__ATOMIC_ACQUIRE, "agent");
            asm volatile("s_waitcnt vmcnt(0)" ::: "memory");
        }
    }
    __syncthreads();
}

constexpr int NPHASE = 23;
__global__ void __launch_bounds__(512, 2) mega_fwd(Params P, int lo, int hi) {
    extern __shared__ __attribute__((aligned(16))) unsigned char lds_raw[];
    cg::grid_group grid = cg::this_grid();
    LAS unsigned char* lds = (LAS unsigned char*)lds_raw;
    unsigned char* ws = P.ws;
    const int G = gridDim.x, bid = blockIdx.x;
    float* mod = (float*)(ws + WS_MOD);
    volatile LAS unsigned* bst = (volatile LAS unsigned*)(lds + (LDS_BYTES - 64));
    if (threadIdx.x < 2) bst[threadIdx.x] = 0u;
    __syncthreads();
    XcdBarrier xbar = xcd_barrier_post((unsigned*)(ws + WS_XBAR), bst);
    unsigned long long* tstamp = (unsigned long long*)(ws + 15 * MiB);
#ifndef PH_ONLY
#define PH_ONLY -1
#endif
#ifndef DUPMASK
#define DUPMASK 0
#endif
#define IN(k) ((PH_ONLY < 0 || PH_ONLY == (k)) && lo <= (k) && (k) < hi)
#define TSTAMP(k) do { if (TPH_LO >= 0 && blockIdx.x == 0 && threadIdx.x == 0) { if ((k) == TPH_LO) tstamp[0] = __builtin_amdgcn_s_memrealtime(); if ((k) == TPH_HI + 1) tstamp[1] = __builtin_amdgcn_s_memrealtime(); } } while (0)
#define SEAM(k) do { if (IN(k) && IN((k) + 1)) xcd_barrier(xbar); } while (0)
    if (hi > 1000) grid.sync();
    TSTAMP(0); if (IN(0)) { phase0(P, lds); } SEAM(0);
#if (DUPMASK >> 0) & 1
    TSTAMP(0); if (IN(0)) { phase0(P, lds); } SEAM(0);
#endif

    TSTAMP(1); if (IN(1)) { norm_phase<0>(P, P.in[I_NMIX], mod + 0 * DM, false); } SEAM(1);
#if (DUPMASK >> 1) & 1
    TSTAMP(1); if (IN(1)) { norm_phase<0>(P, P.in[I_NMIX], mod + 0 * DM, false); } SEAM(1);
#endif

    TSTAMP(2); if (IN(2)) { pg8::Gemm g{(const bf16*)(ws + WS_U), (const bf16*)(ws + WS_WATT), MT, AIWP, 2048, 2048, 0}; pg8::StaticOrder S; S.init(MT, AIWP, G, bid, 0, 2048);
        pg8::EpiStore E{(bf16*)(ws + WS_PROJ), AIWP}; pg8::gemm_phase<pg8::EpiStore, pg8::StaticOrder, true, true>(lds, g, S, E); } SEAM(2);
#if (DUPMASK >> 2) & 1
    TSTAMP(2); if (IN(2)) { pg8::Gemm g{(const bf16*)(ws + WS_U), (const bf16*)(ws + WS_WATT), MT, AIWP, 2048, 2048, 0}; pg8::StaticOrder S; S.init(MT, AIWP, G, bid, 0, 2048);
        pg8::EpiStore E{(bf16*)(ws + WS_PROJ), AIWP}; pg8::gemm_phase<pg8::EpiStore, pg8::StaticOrder, true, true>(lds, g, S, E); } SEAM(2);
#endif

    TSTAMP(3); if (IN(3)) { attn_post_phase(P); } SEAM(3);
#if (DUPMASK >> 3) & 1
    TSTAMP(3); if (IN(3)) { attn_post_phase(P); } SEAM(3);
#endif

    TSTAMP(4); if (IN(4)) {
        { pg8::Gemm g{(const bf16*)(ws + WS_CQN), (const bf16*)(ws + WS_WUQ), MT, 3584, 512, 512, 2}; pg8::StaticOrder S; S.init(MT, 3584, G, bid, 0, 512);
          pg8::EpiMla E{(bf16*)(ws + WS_QB), (bf16*)(ws + WS_KVB)}; pg8::gemm_phase<pg8::EpiMla, pg8::StaticOrder, true, true>(lds, g, S, E); }
    } SEAM(4);
#if (DUPMASK >> 4) & 1
    TSTAMP(4); if (IN(4)) {
        { pg8::Gemm g{(const bf16*)(ws + WS_CQN), (const bf16*)(ws + WS_WUQ), MT, 3584, 512, 512, 2}; pg8::StaticOrder S; S.init(MT, 3584, G, bid, 0, 512);
          pg8::EpiMla E{(bf16*)(ws + WS_QB), (bf16*)(ws + WS_KVB)}; pg8::gemm_phase<pg8::EpiMla, pg8::StaticOrder, true, true>(lds, g, S, E); }
    } SEAM(4);
#endif

    TSTAMP(5); if (IN(5)) { attn_phase(P, (char*)lds_raw); } SEAM(5);
#if (DUPMASK >> 5) & 1
    TSTAMP(5); if (IN(5)) { attn_phase(P, (char*)lds_raw); } SEAM(5);
#endif

    TSTAMP(6); if (IN(6)) { pg8::Gemm g{(const bf16*)(ws + WS_MIX), (const bf16*)(ws + WS_WMIX0), MT, 2048, 2048, 2048, 0}; pg8::StaticOrder S; S.init(MT, 2048, G, bid, 0, 2048, G == 256);
        pg8::EpiResGate E{(float*)(ws + WS_H), mod + 2 * DM, (float*)(ws + WS_PART), 2048 / 64, P.in[I_X], P.in[I_CTX]}; pg8::gemm_phase<pg8::EpiResGate, pg8::StaticOrder, true, true>(lds, g, S, E); } SEAM(6);
#if (DUPMASK >> 6) & 1
    TSTAMP(6); if (IN(6)) { pg8::Gemm g{(const bf16*)(ws + WS_MIX), (const bf16*)(ws + WS_WMIX0), MT, 2048, 2048, 2048, 0}; pg8::StaticOrder S; S.init(MT, 2048, G, bid, 0, 2048, G == 256);
        pg8::EpiResGate E{(float*)(ws + WS_H), mod + 2 * DM, (float*)(ws + WS_PART), 2048 / 64, P.in[I_X], P.in[I_CTX]}; pg8::gemm_phase<pg8::EpiResGate, pg8::StaticOrder, true, true>(lds, g, S, E); } SEAM(6);
#endif

    TSTAMP(7); if (IN(7)) { norm_phase<1>(P, P.in[I_NFFN], mod + 3 * DM, false, G == 256 ? (const float*)(ws + WS_PART) : nullptr, true); } SEAM(7);
#if (DUPMASK >> 7) & 1
    TSTAMP(7); if (IN(7)) { norm_phase<1>(P, P.in[I_NFFN], mod + 3 * DM, false, G == 256 ? (const float*)(ws + WS_PART) : nullptr, true); } SEAM(7);
#endif

    TSTAMP(8); if (IN(8)) { pg8::Gemm g{(const bf16*)(ws + WS_U), (const bf16*)(ws + WS_WGU0), MT, 2 * FFH, 2048, 2048, 0}; pg8::StaticOrder S; S.init(MT, 2 * FFH, G, bid, 0, 2048);
        pg8::EpiSwiGLU E{(bf16*)(ws + WS_HID), FFH}; pg8::gemm_phase<pg8::EpiSwiGLU, pg8::StaticOrder, true, true>(lds, g, S, E); } SEAM(8);
#if (DUPMASK >> 8) & 1
    TSTAMP(8); if (IN(8)) { pg8::Gemm g{(const bf16*)(ws + WS_U), (const bf16*)(ws + WS_WGU0), MT, 2 * FFH, 2048, 2048, 0}; pg8::StaticOrder S; S.init(MT, 2 * FFH, G, bid, 0, 2048);
        pg8::EpiSwiGLU E{(bf16*)(ws + WS_HID), FFH}; pg8::gemm_phase<pg8::EpiSwiGLU, pg8::StaticOrder, true, true>(lds, g, S, E); } SEAM(8);
#endif

    TSTAMP(9); if (IN(9)) { pg8::Gemm g{(const bf16*)(ws + WS_HID), (const bf16*)(ws + WS_WD0), MT, 2048, FFH, FFH, 0}; pg8::StaticOrder S; S.init(MT, 2048, G, bid, 0, FFH, G == 256);
        pg8::EpiResGate E{(float*)(ws + WS_H), mod + 5 * DM, (float*)(ws + WS_PART), FFH / 64, nullptr, nullptr}; pg8::gemm_phase<pg8::EpiResGate, pg8::StaticOrder, true, true>(lds, g, S, E); } SEAM(9);
#if (DUPMASK >> 9) & 1
    TSTAMP(9); if (IN(9)) { pg8::Gemm g{(const bf16*)(ws + WS_HID), (const bf16*)(ws + WS_WD0), MT, 2048, FFH, FFH, 0}; pg8::StaticOrder S; S.init(MT, 2048, G, bid, 0, FFH, G == 256);
        pg8::EpiResGate E{(float*)(ws + WS_H), mod + 5 * DM, (float*)(ws + WS_PART), FFH / 64, nullptr, nullptr}; pg8::gemm_phase<pg8::EpiResGate, pg8::StaticOrder, true, true>(lds, g, S, E); } SEAM(9);
#endif

    float* mod1 = mod + 5 * MODW;
    TSTAMP(10); if (IN(10)) { norm_phase<1>(P, P.in[I_NMIX] + DM, mod1 + 0 * DM, false, G == 256 ? (const float*)(ws + WS_PART) : nullptr); } SEAM(10);
#if (DUPMASK >> 10) & 1
    TSTAMP(10); if (IN(10)) { norm_phase<1>(P, P.in[I_NMIX] + DM, mod1 + 0 * DM, false, G == 256 ? (const float*)(ws + WS_PART) : nullptr); } SEAM(10);
#endif

    TSTAMP(11); if (IN(11)) { pg8::Gemm g{(const bf16*)(ws + WS_U), (const bf16*)(ws + WS_WREC), MT, RIW, 2048, 2048, 0}; pg8::StaticOrder S; S.init(MT, RIW, G, bid, 0, 2048);
        pg8::EpiRec E{(bf16*)(ws + WS_PREC), (bf16*)(ws + WS_HG)}; pg8::gemm_phase<pg8::EpiRec, pg8::StaticOrder, true, true>(lds, g, S, E); } SEAM(11);
#if (DUPMASK >> 11) & 1
    TSTAMP(11); if (IN(11)) { pg8::Gemm g{(const bf16*)(ws + WS_U), (const bf16*)(ws + WS_WREC), MT, RIW, 2048, 2048, 0}; pg8::StaticOrder S; S.init(MT, RIW, G, bid, 0, 2048);
        pg8::EpiRec E{(bf16*)(ws + WS_PREC), (bf16*)(ws + WS_HG)}; pg8::gemm_phase<pg8::EpiRec, pg8::StaticOrder, true, true>(lds, g, S, E); } SEAM(11);
#endif

    TSTAMP(12); if (IN(12)) { conv_phase(P); hg_a_phase(P, lds); } SEAM(12);
#if (DUPMASK >> 12) & 1
    TSTAMP(12); if (IN(12)) { conv_phase(P); hg_a_phase(P, lds); } SEAM(12);
#endif

    TSTAMP(13); if (IN(13)) { hg_b_phase(P); } SEAM(13);
#if (DUPMASK >> 13) & 1
    TSTAMP(13); if (IN(13)) { hg_b_phase(P); } SEAM(13);
#endif

    TSTAMP(14); if (IN(14)) { hg_c_phase(P, lds); } SEAM(14);
#if (DUPMASK >> 14) & 1
    TSTAMP(14); if (IN(14)) { hg_c_phase(P, lds); } SEAM(14);
#endif

    TSTAMP(15); if (IN(15)) { pg8::Gemm g{(const bf16*)(ws + WS_XC), (const bf16*)(ws + WS_WLRU), MT, 4096, 256, 1024, 1}; pg8::StaticOrder S; S.init(MT, 4096, G, bid, 0, 256);
        pg8::EpiStore E{(bf16*)(ws + WS_LAB), 4096}; pg8::gemm_phase<pg8::EpiStore, pg8::StaticOrder, true, true>(lds, g, S, E); } SEAM(15);
#if (DUPMASK >> 15) & 1
    TSTAMP(15); if (IN(15)) { pg8::Gemm g{(const bf16*)(ws + WS_XC), (const bf16*)(ws + WS_WLRU), MT, 4096, 256, 1024, 1}; pg8::StaticOrder S; S.init(MT, 4096, G, bid, 0, 256);
        pg8::EpiStore E{(bf16*)(ws + WS_LAB), 4096}; pg8::gemm_phase<pg8::EpiStore, pg8::StaticOrder, true, true>(lds, g, S, E); } SEAM(15);
#endif

    TSTAMP(16); if (IN(16)) { lru_s1_phase(P); xcd_barrier(xbar); lru_prefix_phase(P); } SEAM(16);
#if (DUPMASK >> 16) & 1
    TSTAMP(16); if (IN(16)) { lru_s1_phase(P); xcd_barrier(xbar); lru_prefix_phase(P); } SEAM(16);
#endif

    TSTAMP(17); if (IN(17)) { lru_s2_phase(P, lds); } SEAM(17);
#if (DUPMASK >> 17) & 1
    TSTAMP(17); if (IN(17)) { lru_s2_phase(P, lds); } SEAM(17);
#endif

    TSTAMP(18); if (IN(18)) { pg8::Gemm g{(const bf16*)(ws + WS_MIX), (const bf16*)(ws + WS_WMIX1), MT, 2048, 2048, 2048, 0}; pg8::StaticOrder S; S.init(MT, 2048, G, bid, 1, 2048);
        pg8::EpiResGate E{(float*)(ws + WS_H), mod1 + 2 * DM, nullptr, 2048 / 64, nullptr, nullptr}; pg8::gemm_phase<pg8::EpiResGate, pg8::StaticOrder, true, true>(lds, g, S, E); } SEAM(18);
#if (DUPMASK >> 18) & 1
    TSTAMP(18); if (IN(18)) { pg8::Gemm g{(const bf16*)(ws + WS_MIX), (const bf16*)(ws + WS_WMIX1), MT, 2048, 2048, 2048, 0}; pg8::StaticOrder S; S.init(MT, 2048, G, bid, 1, 2048);
        pg8::EpiResGate E{(float*)(ws + WS_H), mod1 + 2 * DM, nullptr, 2048 / 64, nullptr, nullptr}; pg8::gemm_phase<pg8::EpiResGate, pg8::StaticOrder, true, true>(lds, g, S, E); } SEAM(18);
#endif

    TSTAMP(19); if (IN(19)) { norm_phase<1>(P, P.in[I_NFFN] + DM, mod1 + 3 * DM, true); } SEAM(19);
#if (DUPMASK >> 19) & 1
    TSTAMP(19); if (IN(19)) { norm_phase<1>(P, P.in[I_NFFN] + DM, mod1 + 3 * DM, true); } SEAM(19);
#endif

    TSTAMP(20); if (IN(20)) { pg8::Gemm g{(const bf16*)(ws + WS_U), (const bf16*)(ws + WS_WGU1), MT, 2 * FFH, 2048, 2048, 0}; pg8::StaticOrder S; S.init(MT, 2 * FFH, G, bid, 1, 2048);
        pg8::EpiSwiGLU E{(bf16*)(ws + WS_HID), FFH}; pg8::gemm_phase<pg8::EpiSwiGLU, pg8::StaticOrder, true, true>(lds, g, S, E); } SEAM(20);
#if (DUPMASK >> 20) & 1
    TSTAMP(20); if (IN(20)) { pg8::Gemm g{(const bf16*)(ws + WS_U), (const bf16*)(ws + WS_WGU1), MT, 2 * FFH, 2048, 2048, 0}; pg8::StaticOrder S; S.init(MT, 2 * FFH, G, bid, 1, 2048);
        pg8::EpiSwiGLU E{(bf16*)(ws + WS_HID), FFH}; pg8::gemm_phase<pg8::EpiSwiGLU, pg8::StaticOrder, true, true>(lds, g, S, E); } SEAM(20);
#endif

    TSTAMP(21); if (IN(21)) { pg8::Gemm g{(const bf16*)(ws + WS_HID), (const bf16*)(ws + WS_WD1), MT, 2048, FFH, FFH, 0}; pg8::StaticOrder S; S.init(MT, 2048, G, bid, 1, FFH);
        pg8::EpiResGate E{(float*)(ws + WS_H), mod1 + 5 * DM, nullptr, FFH / 64, nullptr, nullptr}; pg8::gemm_phase<pg8::EpiResGate, pg8::StaticOrder, true, true>(lds, g, S, E); } SEAM(21);
#if (DUPMASK >> 21) & 1
    TSTAMP(21); if (IN(21)) { pg8::Gemm g{(const bf16*)(ws + WS_HID), (const bf16*)(ws + WS_WD1), MT, 2048, FFH, FFH, 0}; pg8::StaticOrder S; S.init(MT, 2048, G, bid, 1, FFH);
        pg8::EpiResGate E{(float*)(ws + WS_H), mod1 + 5 * DM, nullptr, FFH / 64, nullptr, nullptr}; pg8::gemm_phase<pg8::EpiResGate, pg8::StaticOrder, true, true>(lds, g, S, E); } SEAM(21);
#endif

    TSTAMP(22); if (IN(22)) { norm_phase<2>(P, P.in[I_FNW], nullptr, true); }
#undef IN
#undef SEAM
}

extern "C" void kernel_launch(void* const* d_in, const int* in_sizes, int n_in, void* d_out, int out_size, void* d_ws, size_t ws_size, hipStream_t stream) {
    static int grid = 0;
    if (grid == 0) {
        if (n_in != 30 || ws_size < WS_END) { fprintf(stderr, "kernel_launch: n_in %d ws %zu (need 30, >= %zu)\n", n_in, ws_size, (size_t)WS_END); }
        int dev = 0, cus = 0, per_cu = 0;
        hipGetDevice(&dev); hipDeviceGetAttribute(&cus, hipDeviceAttributeMultiprocessorCount, dev);
        if (hipFuncSetAttribute((const void*)mega_fwd, hipFuncAttributeMaxDynamicSharedMemorySize, LDS_BYTES) != hipSuccess) fprintf(stderr, "kernel_launch: hipFuncSetAttribute failed\n");
        if (hipOccupancyMaxActiveBlocksPerMultiprocessor(&per_cu, (const void*)mega_fwd, 512, LDS_BYTES) != hipSuccess || per_cu < 1) { fprintf(stderr, "kernel_launch: occupancy query says %d\n", per_cu); per_cu = 1; }
        (void)hipGetLastError();
        grid = cus * 1;
        if (grid <= 0) grid = 256;
    }
    (void)hipMemsetAsync((char*)d_ws + WS_XBAR, 0, 16384, stream);
    Params p{};
    for (int i = 0; i < 30; ++i) p.in[i] = (const float*)d_in[i];
    p.out = (float*)d_out; p.ws = (unsigned char*)d_ws;
    int lo = 0, hi = NPHASE;
    void* args[] = {(void*)&p, (void*)&lo, (void*)&hi};
    hipError_t e = hipLaunchCooperativeKernel((const void*)mega_fwd, dim3(grid), dim3(512), args, LDS_BYTES, stream);
    if (e != hipSuccess) fprintf(stderr, "kernel_launch: cooperative launch failed: %s (grid %d)\n", hipGetErrorString(e), grid);
}
```
